# Optimizing an MI355X kernel written in HIP

```python
import math
import jax, jax.numpy as jnp
from jax import lax
import numpy as np

D_MODEL = 4096
BATCH = 4
SEQ = 4096
DEPTH = 1

SSM_WIDTH = D_MODEL // 2
SSM_GROUP = 16
SSM_GROUPS = SSM_WIDTH // SSM_GROUP
SSM_STATE = 64
DT_MIN = 1e-3
DT_MAX = 1e-1
N_HEADS = 16
HEAD_DIM = 128
N_KV = 4
HPG = N_HEADS // N_KV
ATT_WIDTH = N_HEADS * HEAD_DIM
KV_WIDTH = N_KV * HEAD_DIM
L_CMP = 32
STRIDE_CMP = 16
L_SEL = 64
N_SEL = 16
WINDOW = 512
Q_BLOCK = 128
SEL_Q_BLOCK = 64
D_FF = ((8 * D_MODEL // 3 + 255) // 256) * 256
RMS_EPS = 1e-6
NEG_INF = -1e30
FORCE_SCORE = 1e9
IN_SPLITS = (SSM_WIDTH, ATT_WIDTH, KV_WIDTH, KV_WIDTH, KV_WIDTH, KV_WIDTH, KV_WIDTH, KV_WIDTH, 3 * N_HEADS, D_MODEL, D_MODEL)
IN_WIDTH = SSM_WIDTH + ATT_WIDTH + 6 * KV_WIDTH + 3 * N_HEADS + 2 * D_MODEL

kernel_name = "hybrid_s5_nsa_gated_block"


def rms_norm(x, gain):
    xf = x.astype(jnp.float32)
    y = xf * lax.rsqrt(jnp.mean(xf * xf, axis=-1, keepdims=True) + RMS_EPS)
    return (y * gain.astype(jnp.float32)).astype(x.dtype)


def _ssm_combine(e1, e2):
    a1r, a1i, b1r, b1i = e1
    a2r, a2i, b2r, b2i = e2
    return (a1r * a2r - a1i * a2i,
            a1r * a2i + a1i * a2r,
            a2r * b1r - a2i * b1i + b2r,
            a2r * b1i + a2i * b1r + b2i)


def s5_mixer(u, a_re, a_im, log_dt, b_re, b_im, c_re, c_im, d_skip, w_glu, b_glu):
    f32 = jnp.float32
    bsz, seq, _ = u.shape
    uf = u.astype(f32).reshape(bsz, seq, SSM_GROUPS, SSM_GROUP)
    ar, ai = a_re.astype(f32), a_im.astype(f32)
    dt = jnp.exp(log_dt.astype(f32))[:, None]
    decay = jnp.exp(dt * ar)
    abar_r, abar_i = decay * jnp.cos(dt * ai), decay * jnp.sin(dt * ai)
    den = ar * ar + ai * ai
    zr = ((abar_r - 1.0) * ar + abar_i * ai) / den
    zi = (abar_i * ar - (abar_r - 1.0) * ai) / den
    br, bi = b_re.astype(f32), b_im.astype(f32)
    bbar_r = zr[..., None] * br - zi[..., None] * bi
    bbar_i = zr[..., None] * bi + zi[..., None] * br
    bu_r = jnp.einsum('gpc,bsgc->bsgp', bbar_r, uf)
    bu_i = jnp.einsum('gpc,bsgc->bsgp', bbar_i, uf)
    a_shape = (1, seq, SSM_GROUPS, SSM_STATE)
    elems = (jnp.broadcast_to(abar_r, a_shape), jnp.broadcast_to(abar_i, a_shape), bu_r, bu_i)
    _, _, h_r, h_i = lax.associative_scan(_ssm_combine, elems, axis=1)
    y = (jnp.einsum('gcp,bsgp->bsgc', c_re.astype(f32), h_r)
         - jnp.einsum('gcp,bsgp->bsgc', c_im.astype(f32), h_i)
         + d_skip.astype(f32).reshape(SSM_GROUPS, SSM_GROUP) * uf)
    y = jax.nn.gelu(y.reshape(bsz, seq, SSM_WIDTH))
    y = y * jax.nn.sigmoid(y @ w_glu.astype(f32) + b_glu.astype(f32))
    return y.astype(u.dtype)


def _compress(k, pe, w1, w2):
    bsz, seq = k.shape[:2]
    n_cmp = (seq - L_CMP) // STRIDE_CMP + 1
    idx = np.arange(n_cmp)[:, None] * STRIDE_CMP + np.arange(L_CMP)[None, :]
    blk = k[:, idx] + pe[:, None, :]
    blk = jnp.moveaxis(blk, 3, 2).reshape(bsz, n_cmp, N_KV, L_CMP * HEAD_DIM)
    return jax.nn.gelu(blk @ w1) @ w2


def nsa_mixer(q, k_c, v_c, k_s, v_s, k_w, v_w, gate_logits, pe_k, w1_k, w2_k, pe_v, w1_v, w2_v):
    f32 = jnp.float32
    bsz, seq = q.shape[:2]
    q = q.reshape(bsz, seq, N_KV, HPG, HEAD_DIM) * (HEAD_DIM ** -0.5)
    k_c, v_c, k_s, v_s, k_w, v_w = [a.reshape(bsz, seq, N_KV, HEAD_DIM) for a in (k_c, v_c, k_s, v_s, k_w, v_w)]
    t = jnp.arange(seq)

    n_cmp = (seq - L_CMP) // STRIDE_CMP + 1
    kc = _compress(k_c, pe_k, w1_k, w2_k)
    vc = _compress(v_c, pe_v, w1_v, w2_v)
    blk_end = jnp.arange(n_cmp) * STRIDE_CMP + (L_CMP - 1)
    cmp_ok = blk_end[None, :] <= t[:, None]
    s = jnp.einsum('bsghd,bngd->bghsn', q, kc).astype(f32)
    p_cmp = jax.nn.softmax(jnp.where(cmp_ok, s, NEG_INF), axis=-1) * cmp_ok
    o_cmp = jnp.einsum('bghsn,bngd->bsghd', p_cmp.astype(q.dtype), vc)

    n_blk = seq // L_SEL
    n_top = min(N_SEL, n_blk)
    ci = np.arange(n_cmp)[:, None]
    sj = np.arange(n_blk)[None, :]
    overlap = ((ci * STRIDE_CMP < (sj + 1) * L_SEL) & (ci * STRIDE_CMP + L_CMP > sj * L_SEL)).astype(np.float32)
    imp = jnp.einsum('bghsn,nj->bgsj', p_cmp, jnp.asarray(overlap))
    blk = jnp.arange(n_blk)[None, :]
    cur = (t // L_SEL)[:, None]
    allowed = blk * L_SEL <= t[:, None]
    forced = (blk == 0) | (blk == cur) | (blk == cur - 1)
    score = jnp.where(forced, FORCE_SCORE, jnp.where(allowed, imp, NEG_INF))
    _, sel_idx = lax.top_k(score, n_top)

    k_blk = k_s.reshape(bsz, n_blk, L_SEL, N_KV, HEAD_DIM).transpose(0, 3, 1, 2, 4)
    v_blk = v_s.reshape(bsz, n_blk, L_SEL, N_KV, HEAD_DIM).transpose(0, 3, 1, 2, 4)
    n_qc = seq // SEL_Q_BLOCK
    q_chunks = jnp.moveaxis(q.reshape(bsz, n_qc, SEL_Q_BLOCK, N_KV, HPG, HEAD_DIM), 1, 0)
    idx_chunks = jnp.moveaxis(sel_idx.reshape(bsz, N_KV, n_qc, SEL_Q_BLOCK, n_top), 2, 0)
    t_chunks = t.reshape(n_qc, SEL_Q_BLOCK)
    b_ix = jnp.arange(bsz)[:, None, None, None]
    g_ix = jnp.arange(N_KV)[None, :, None, None]
    offs = jnp.arange(L_SEL)

    def sel_block(args):
        qc, ic, tc = args
        kg = k_blk[b_ix, g_ix, ic]
        vg = v_blk[b_ix, g_ix, ic]
        pos = ic[..., None] * L_SEL + offs
        ok = (pos <= tc[None, None, :, None, None])[:, :, None]
        sc = jnp.einsum('bqghd,bgqkld->bghqkl', qc, kg).astype(f32)
        p = jax.nn.softmax(jnp.where(ok, sc, NEG_INF), axis=(-2, -1))
        return jnp.einsum('bghqkl,bgqkld->bqghd', p.astype(qc.dtype), vg)

    o_sel = lax.map(sel_block, (q_chunks, idx_chunks, t_chunks))
    o_sel = jnp.moveaxis(o_sel, 0, 1).reshape(bsz, seq, N_KV, HPG, HEAD_DIM)

    nb = seq // Q_BLOCK
    nw = WINDOW // Q_BLOCK

    def band(a):
        ab = a.reshape(bsz, nb, Q_BLOCK, N_KV, HEAD_DIM)
        ap = jnp.pad(ab, ((0, 0), (nw, 0), (0, 0), (0, 0), (0, 0)))
        return jnp.concatenate([ap[:, j:j + nb] for j in range(nw + 1)], axis=2)

    kwb, vwb = band(k_w), band(v_w)
    qpos = t.reshape(nb, Q_BLOCK)
    kpos = (jnp.arange(nb)[:, None] - nw) * Q_BLOCK + jnp.arange((nw + 1) * Q_BLOCK)[None, :]
    diff = qpos[:, :, None] - kpos[:, None, :]
    win_ok = (diff >= 0) & (diff < WINDOW) & (kpos[:, None, :] >= 0)
    qb = q.reshape(bsz, nb, Q_BLOCK, N_KV, HPG, HEAD_DIM)
    sw = jnp.einsum('bnqghd,bnkgd->bghnqk', qb, kwb).astype(f32)
    pw = jax.nn.softmax(jnp.where(win_ok, sw, NEG_INF), axis=-1)
    o_win = jnp.einsum('bghnqk,bnkgd->bnqghd', pw.astype(q.dtype), vwb).reshape(bsz, seq, N_KV, HPG, HEAD_DIM)

    g = jax.nn.sigmoid(gate_logits.astype(f32)).reshape(bsz, seq, 3, N_KV, HPG, 1).astype(q.dtype)
    o = g[:, :, 0] * o_cmp + g[:, :, 1] * o_sel + g[:, :, 2] * o_win
    return o.reshape(bsz, seq, ATT_WIDTH)


def setup_inputs(seed: int = 0) -> dict:
    key = jax.random.key(seed)
    ks = jax.random.split(key, 32)
    f32 = jnp.float32
    L = DEPTH

    def nrm(k, shape, scale):
        return jax.random.normal(k, shape, f32) * scale

    def gain(k, width):
        return 1.0 + 0.05 * jax.random.normal(k, (L, width), f32)

    n_idx = jnp.arange(SSM_STATE, dtype=f32)
    return {
        "x": nrm(ks[0], (BATCH, SEQ, D_MODEL), 1.0),
        "norm_mix_pre": gain(ks[1], D_MODEL),
        "w_in": nrm(ks[2], (L, D_MODEL, IN_WIDTH), D_MODEL ** -0.5),
        "ssm_a_re": -0.5 * jnp.exp(0.05 * jax.random.normal(ks[3], (L, SSM_GROUPS, SSM_STATE), f32)),
        "ssm_a_im": math.pi * n_idx + 0.05 * jax.random.normal(ks[4], (L, SSM_GROUPS, SSM_STATE), f32),
        "ssm_log_dt": jax.random.uniform(ks[5], (L, SSM_GROUPS), f32, math.log(DT_MIN), math.log(DT_MAX)),
        "ssm_b_re": nrm(ks[6], (L, SSM_GROUPS, SSM_STATE, SSM_GROUP), (2 * SSM_GROUP) ** -0.5),
        "ssm_b_im": nrm(ks[7], (L, SSM_GROUPS, SSM_STATE, SSM_GROUP), (2 * SSM_GROUP) ** -0.5),
        "ssm_c_re": nrm(ks[8], (L, SSM_GROUPS, SSM_GROUP, SSM_STATE), (2 * SSM_STATE) ** -0.5),
        "ssm_c_im": nrm(ks[9], (L, SSM_GROUPS, SSM_GROUP, SSM_STATE), (2 * SSM_STATE) ** -0.5),
        "ssm_d": nrm(ks[10], (L, SSM_WIDTH), 1.0),
        "ssm_w_glu": nrm(ks[11], (L, SSM_WIDTH, SSM_WIDTH), SSM_WIDTH ** -0.5),
        "ssm_b_glu": nrm(ks[12], (L, SSM_WIDTH), 0.01),
        "cmp_pe_k": nrm(ks[13], (L, L_CMP, HEAD_DIM), 0.1),
        "cmp_w1_k": nrm(ks[14], (L, L_CMP * HEAD_DIM, HEAD_DIM), (L_CMP * HEAD_DIM) ** -0.5),
        "cmp_w2_k": nrm(ks[15], (L, HEAD_DIM, HEAD_DIM), HEAD_DIM ** -0.5),
        "cmp_pe_v": nrm(ks[16], (L, L_CMP, HEAD_DIM), 0.1),
        "cmp_w1_v": nrm(ks[17], (L, L_CMP * HEAD_DIM, HEAD_DIM), (L_CMP * HEAD_DIM) ** -0.5),
        "cmp_w2_v": nrm(ks[18], (L, HEAD_DIM, HEAD_DIM), HEAD_DIM ** -0.5),
        "w_proj_a": nrm(ks[19], (L, SSM_WIDTH, D_MODEL), SSM_WIDTH ** -0.5),
        "w_proj_b": nrm(ks[20], (L, ATT_WIDTH, D_MODEL), ATT_WIDTH ** -0.5),
        "w_out": nrm(ks[21], (L, D_MODEL, D_MODEL), D_MODEL ** -0.5),
        "norm_mix_post": gain(ks[22], D_MODEL),
        "norm_ffn_pre": gain(ks[23], D_MODEL),
        "w_ffn_gate": nrm(ks[24], (L, D_MODEL, D_FF), D_MODEL ** -0.5),
        "w_ffn_up": nrm(ks[25], (L, D_MODEL, D_FF), D_MODEL ** -0.5),
        "w_ffn_down": nrm(ks[26], (L, D_FF, D_MODEL), D_FF ** -0.5),
        "norm_ffn_post": gain(ks[27], D_MODEL),
    }


def reference(x, norm_mix_pre, w_in, ssm_a_re, ssm_a_im, ssm_log_dt, ssm_b_re, ssm_b_im, ssm_c_re, ssm_c_im,
              ssm_d, ssm_w_glu, ssm_b_glu, cmp_pe_k, cmp_w1_k, cmp_w2_k, cmp_pe_v, cmp_w1_v, cmp_w2_v,
              w_proj_a, w_proj_b, w_out, norm_mix_post, norm_ffn_pre, w_ffn_gate, w_ffn_up, w_ffn_down,
              norm_ffn_post):
    split_at = [int(v) for v in np.cumsum(IN_SPLITS)[:-1]]
    h = x
    for l in range(DEPTH):
        hn = rms_norm(h, norm_mix_pre[l])
        proj = hn @ w_in[l]
        u, q, kc, vc, ks_, vs_, kw, vw, g_nsa, g_a, g_b = jnp.split(proj, split_at, axis=-1)
        y_a = s5_mixer(u, ssm_a_re[l], ssm_a_im[l], ssm_log_dt[l], ssm_b_re[l], ssm_b_im[l],
                       ssm_c_re[l], ssm_c_im[l], ssm_d[l], ssm_w_glu[l], ssm_b_glu[l])
        y_b = nsa_mixer(q, kc, vc, ks_, vs_, kw, vw, g_nsa, cmp_pe_k[l], cmp_w1_k[l], cmp_w2_k[l],
                        cmp_pe_v[l], cmp_w1_v[l], cmp_w2_v[l])
        merged = jax.nn.sigmoid(g_a) * (y_a @ w_proj_a[l]) + jax.nn.sigmoid(g_b) * (y_b @ w_proj_b[l])
        h = h + rms_norm(merged @ w_out[l], norm_mix_post[l])
        hn = rms_norm(h, norm_ffn_pre[l])
        f = (jax.nn.silu(hn @ w_ffn_gate[l]) * (hn @ w_ffn_up[l])) @ w_ffn_down[l]
        h = h + rms_norm(f, norm_ffn_post[l])
    return h
```

```cpp
#include <hip/hip_runtime.h>
#include <cstdio>
#include <cstdint>

#ifndef MK_PER_PHASE
#define MK_PER_PHASE 0
#endif

#define LAS __attribute__((address_space(3)))
#define GAS __attribute__((address_space(1)))
typedef unsigned short bf16_t;
typedef short bf16x8 __attribute__((ext_vector_type(8)));
typedef short s16x4 __attribute__((ext_vector_type(4)));
typedef float f32x4 __attribute__((ext_vector_type(4)));
typedef float f32x2 __attribute__((ext_vector_type(2)));
typedef float f32x16 __attribute__((ext_vector_type(16)));
typedef unsigned u32x4 __attribute__((ext_vector_type(4)));
typedef unsigned u32x2 __attribute__((ext_vector_type(2)));
typedef GAS unsigned gu32;

constexpr int DM = 4096, BATCH = 4, SEQ = 4096, M = BATCH * SEQ;
constexpr int SSMW = 2048, NGRP = 128, GC = 16, NST = 64;
constexpr int NH = 16, HD = 128, NKV = 4, HPG = 4, ATTW = 2048, KVW = 512;
constexpr int DFF = 11008;
constexpr int INW = 15408;
constexpr int NCMP = 255;
constexpr float RMS_EPS = 1e-6f;

constexpr size_t MiB = 1u << 20;
constexpr size_t WS_CTL = 0, CTL_ZERO_BYTES = 32768;
constexpr size_t WS_SSMP = 1 * MiB;
constexpr size_t WS_CB1 = 3 * MiB;
constexpr size_t WS_W1T = 4 * MiB;
constexpr size_t WS_W2T = 6 * MiB;
constexpr size_t WS_KC = 7 * MiB;
constexpr size_t WS_WGN = 9 * MiB;
constexpr size_t WS_STT = 12 * MiB;
constexpr size_t WS_TGT = 20 * MiB;
constexpr size_t WS_GN = 44 * MiB;
constexpr size_t WS_WGLU = 60 * MiB;
constexpr size_t WS_WAB = 68 * MiB;
constexpr size_t WS_WOUT = 100 * MiB;
constexpr size_t WS_WDN = 132 * MiB;
constexpr size_t WS_WGU = 218 * MiB;
constexpr size_t WS_R1 = 390 * MiB;
constexpr size_t WS_R2 = 518 * MiB;
constexpr size_t WS_R3 = 646 * MiB;
constexpr size_t WS_UH = WS_R3;
constexpr size_t WS_Q = WS_UH + 96 * MiB;
constexpr size_t WS_KV = WS_Q + 64 * MiB;
constexpr size_t WS_GA = WS_KV + 96 * MiB;
constexpr size_t WS_GB = WS_GA + 128 * MiB;
constexpr size_t WS_END = WS_GB + 128 * MiB;
constexpr size_t WS_WIN = WS_R1, WS_YAB = WS_R1, WS_F = WS_R1;
constexpr size_t WS_WG8 = WS_R1 + 56 * MiB;
constexpr size_t WS_HN8 = WS_GB + 64 * MiB;
constexpr float GATE_WSCALE = 128.f;
constexpr size_t WS_HC = WS_R1;
constexpr size_t WS_CP = WS_R1 + 64 * MiB;
constexpr size_t WS_HN = WS_R2;
constexpr size_t WS_Y = WS_R2;
constexpr size_t WS_ACC = WS_R2 + 64 * MiB;
constexpr size_t WS_MRG = WS_Q;
constexpr size_t WS_O = WS_GA;
constexpr size_t WS_A2 = WS_R3;
constexpr size_t WS_SS1 = WS_UH;
constexpr size_t WS_SS2 = WS_R3 + 344 * MiB;
constexpr size_t WS_H1B = WS_GA + 128 * MiB;
static_assert(WS_A2 + (size_t)M * DFF * 2 <= WS_SS2 && WS_SS2 + 4 * MiB <= WS_H1B && WS_O + 128 * MiB <= WS_H1B && WS_H1B + 128 * MiB <= WS_END, "a | ss2 | h1b fit");
static_assert(WS_WGU + (size_t)22016 * 4096 * 2 <= WS_R1, "wgu fits");
static_assert(WS_WDN + (size_t)4096 * 11008 * 2 <= WS_WGU, "wdn fits");

constexpr int CW_TMO = 0;
constexpr int CW_BAR = 4096;

constexpr int RING_BYTES = 131072;
constexpr int LDSCTL_OFF = RING_BYTES, MISC_OFF = LDSCTL_OFF + 320;
constexpr int LDS_BYTES = 147456;
constexpr int NWAVES = 8;

__device__ __forceinline__ unsigned cvt_pk_bf16(float lo, float hi) { unsigned r; asm volatile("v_cvt_pk_bf16_f32 %0, %1, %2" : "=v"(r) : "v"(lo), "v"(hi)); return r; }
__device__ __forceinline__ unsigned f2bf(float f) { unsigned u = __builtin_bit_cast(unsigned, f); return (u + 0x7fffu + ((u >> 16) & 1u)) >> 16; }
__device__ __forceinline__ unsigned pk2(float lo, float hi) { return f2bf(lo) | (f2bf(hi) << 16); }
__device__ __forceinline__ float bf_lo(unsigned w) { return __builtin_bit_cast(float, w << 16); }
__device__ __forceinline__ float bf_hi(unsigned w) { return __builtin_bit_cast(float, w & 0xffff0000u); }
__device__ __forceinline__ float sigmoidf_(float x) { return __builtin_amdgcn_rcpf(1.0f + __builtin_amdgcn_exp2f(-1.4426950408889634f * x)); }
__device__ __forceinline__ float gelu_tanh(float x) { const float u = 1.5957691216057308f * (x + 0.044715f * x * x * x); return x * sigmoidf_(u); }
__device__ __forceinline__ float wave_sum(float v) {
#pragma unroll
    for (int o = 1; o < 64; o <<= 1) v += __shfl_xor(v, o);
    return v;
}
__device__ __forceinline__ int lane_id_v() { int l; asm volatile("v_mbcnt_lo_u32_b32 %0, -1, 0\n\tv_mbcnt_hi_u32_b32 %0, -1, %0" : "=v"(l)); return l; }
#define LDS_WAIT() asm volatile("s_waitcnt lgkmcnt(0)" ::: "memory")
#define VM_WAIT() asm volatile("s_waitcnt vmcnt(0)" ::: "memory")

namespace pg8 {
constexpr int BM = 256, BK = 64, HALF = 128, HTB = HALF * BK * 2, STAGE_BYTES = 8 * HTB, NXCD = 8, WGM = 8;
__host__ __device__ __forceinline__ int lds_byte(int r, int c) { const int st = (r >> 4) * 2 + (c >> 5), rr = r & 15, cc = c & 31, ob = rr * 64 + cc * 2; return st * 1024 + (ob ^ (((ob >> 9) & 1) << 5)); }
__host__ __device__ __forceinline__ void stage_rc(int b, int& R, int& C) { const int st = b / 1024, sb = b % 1024, swz = sb ^ (((sb >> 9) & 1) << 5); R = (st >> 1) * 16 + swz / 64; C = (st & 1) * 32 + (swz % 64) / 2; }
__host__ __device__ __forceinline__ int perm32(int rho) { const int n = rho >> 4, i = rho & 15; return 8 * (i >> 2) + 4 * n + (i & 3); }

struct GUnit { const char* a; const char* b; int pm, pn; };
struct Geo { size_t rsA, rsB, kstepA, kstepB, hstepA, hstepB; int nt; };

struct OrdStd {
    const char* A; const char* B; size_t amul, apn, bpn; int nM, nN, nwg, G, c, wgm;
    __device__ __forceinline__ void init(const void* A_, const void* B_, size_t amul_, size_t apn_, size_t bpn_, int nM_, int nN_, int G_, int c_, int wgm_ = WGM) {
        A = (const char*)A_; B = (const char*)B_; amul = amul_; apn = apn_; bpn = bpn_; nM = nM_; nN = nN_; nwg = nM * nN; G = G_; c = c_; wgm = wgm_; }
    __device__ __forceinline__ bool next(int i, GUnit& u) const {
        const long L = (long)i * G + c; if (L >= nwg) return false;
        int wgid = (int)L; { const int q = nwg / NXCD, r = nwg % NXCD, xcd = wgid % NXCD, off = wgid / NXCD; wgid = (xcd < r ? xcd * (q + 1) : r * (q + 1) + (xcd - r) * q) + off; }
        const int nig = wgm * nN, gid = wgid / nig, fm = gid * wgm, gsz = (nM - fm) < wgm ? (nM - fm) : wgm;
        u.pm = fm + ((wgid % nig) % gsz); u.pn = (wgid % nig) / gsz;
        u.a = A + (size_t)u.pm * amul + (size_t)u.pn * apn; u.b = B + (size_t)u.pn * bpn; return true;
    }
};

__device__ __forceinline__ void glds16_s(const void* sbase, unsigned voff, unsigned lds_dst) {
    unsigned keep;
    asm volatile("s_mov_b32 %0, m0\n\ts_mov_b32 m0, %3\n\ts_nop 0\n\tglobal_load_lds_dwordx4 %1, %2\n\ts_mov_b32 m0, %0" : "=&s"(keep) : "v"(voff), "s"(sbase), "s"(lds_dst) : "memory");
}
typedef int v8i_t __attribute__((ext_vector_type(8)));
typedef int i32x4_t __attribute__((ext_vector_type(4)));
template <class Epi, class Sched, bool FP8 = false>
__device__ __forceinline__ void gemm_phase(LAS unsigned char* lds, const Geo g, const Sched& S, const Epi& E) {
    const int lane = lane_id_v(), wid = __builtin_amdgcn_readfirstlane(threadIdx.x >> 6), tid = wid * 64 + lane, wr = wid >> 2, wc = wid & 3, fr = lane & 15, fq = lane >> 4;
    const int nt = g.nt;
    unsigned voffA[2], voffB[2];
#pragma unroll
    for (int i = 0; i < 2; ++i) { int R, C; stage_rc(tid * 16 + i * 8192, R, C); const int Rb = Epi::PERM ? ((R & ~31) + perm32(R & 31)) : R;
        voffA[i] = (unsigned)((size_t)R * g.rsA + (size_t)C * 2u); voffB[i] = (unsigned)((size_t)Rb * g.rsB + (size_t)C * 2u); }
    const size_t kstepA = g.kstepA, kstepB = g.kstepB, hstepA = g.hstepA, hstepB = g.hstepB;
    const unsigned ldsw = (unsigned)wid * 1024u;
    const int aoff = lds_byte(wr * 64 + fr, fq * 8), boff = lds_byte(wc * 32 + fr, fq * 8);
#define PG8_SA(b, h) (((b) * 2 + (h)) * HTB)
#define PG8_SB(b, h) ((4 + (b) * 2 + (h)) * HTB)
#define PG8_STAGE(bufoff, gbase, voff) do { _Pragma("unroll") for (int _i = 0; _i < 2; ++_i) { \
        if constexpr (FP8) glds16_s((const void*)(gbase), (voff)[_i], (unsigned)(uintptr_t)(lds + (bufoff) + ldsw + _i * 8192)); \
        else __builtin_amdgcn_global_load_lds((const unsigned*)((const char*)(gbase) + (voff)[_i]), (LAS unsigned*)(lds + (bufoff) + ldsw + _i * 8192), 16, 0, 0); } } while (0)
#define PG8_LD2(base) __builtin_shufflevector(*(const LAS i32x4_t*)(base), *(const LAS i32x4_t*)((base) + 1024), 0, 1, 2, 3, 4, 5, 6, 7)
#define PG8_LDA(dst, b, h) do { if constexpr (FP8) { _Pragma("unroll") for (int m = 0; m < 4; ++m) dst##8[m] = PG8_LD2(lds + PG8_SA(b, h) + aoff + m * 2048); } \
        else { _Pragma("unroll") for (int m = 0; m < 4; ++m) _Pragma("unroll") for (int k = 0; k < 2; ++k) dst[m][k] = *(const LAS bf16x8*)(lds + PG8_SA(b, h) + aoff + m * 2048 + k * 1024); } } while (0)
#define PG8_LDB(dst, b, h) do { if constexpr (FP8) { _Pragma("unroll") for (int n = 0; n < 2; ++n) dst##8[n] = PG8_LD2(lds + PG8_SB(b, h) + boff + n * 2048); } \
        else { _Pragma("unroll") for (int n = 0; n < 2; ++n) _Pragma("unroll") for (int k = 0; k < 2; ++k) dst[n][k] = *(const LAS bf16x8*)(lds + PG8_SB(b, h) + boff + n * 2048 + k * 1024); } } while (0)
#define PG8_MMA(ai, bj, At, Bt) do { __builtin_amdgcn_s_setprio(1); \
        if constexpr (FP8) { _Pragma("unroll") for (int m = 0; m < 4; ++m) _Pragma("unroll") for (int n = 0; n < 2; ++n) \
            acc[ai][bj][m][n] = __builtin_amdgcn_mfma_scale_f32_16x16x128_f8f6f4(Bt##8[n], At##8[m], acc[ai][bj][m][n], 0, 0, 0, 0x7f7f7f7f, 0, 0x7f7f7f7f); } \
        else { _Pragma("unroll") for (int m = 0; m < 4; ++m) _Pragma("unroll") for (int n = 0; n < 2; ++n) _Pragma("unroll") for (int k = 0; k < 2; ++k) \
            acc[ai][bj][m][n] = __builtin_amdgcn_mfma_f32_16x16x32_bf16(Bt[n][k], At[m][k], acc[ai][bj][m][n], 0, 0, 0); } \
        __builtin_amdgcn_s_setprio(0); } while (0)
#define PG8_WAIT_V(n) asm volatile("s_waitcnt vmcnt(" #n ")" ::: "memory")
#define PG8_WAIT_L(n) asm volatile("s_waitcnt lgkmcnt(" #n ")" ::: "memory")
#define PG8_BAR __builtin_amdgcn_s_barrier()
#define PG8_SCHED __builtin_amdgcn_sched_barrier(0)
    GUnit cur, nxt; int ui = 0;
    if (!S.next(0, cur)) return;
    f32x4 acc[2][2][4][2];
#pragma unroll
    for (int a = 0; a < 2; ++a)
#pragma unroll
        for (int b = 0; b < 2; ++b)
#pragma unroll
            for (int m = 0; m < 4; ++m)
#pragma unroll
                for (int n = 0; n < 2; ++n) acc[a][b][m][n] = (f32x4){0.f, 0.f, 0.f, 0.f};
    bf16x8 At[4][2], B0[2][2], B1[2][2];
    v8i_t At8[4], B08[2], B18[2];
    const char* cA = cur.a; const char* cB = cur.b;
    PG8_STAGE(PG8_SB(0, 0), cB, voffB); PG8_STAGE(PG8_SB(0, 1), cB + hstepB, voffB); PG8_STAGE(PG8_SA(0, 0), cA, voffA); PG8_STAGE(PG8_SA(0, 1), cA + hstepA, voffA);
    if (wr == 1) PG8_BAR;
    PG8_WAIT_V(2); PG8_BAR;
    PG8_STAGE(PG8_SB(1, 0), cB + kstepB, voffB); PG8_STAGE(PG8_SA(1, 0), cA + kstepA, voffA); PG8_STAGE(PG8_SB(1, 1), cB + hstepB + kstepB, voffB);
    PG8_WAIT_V(6); PG8_BAR;
    for (;;) {
        const bool has_next = S.next(ui + 1, nxt);
        const char* nA = has_next ? nxt.a : cA; const char* nB = has_next ? nxt.b : cB;
        for (int t = 0; t < nt; t += 2) {
            const bool last = (t == nt - 2);
            const char* a1 = cA + (size_t)(t + 1) * kstepA;
            const char* a2 = last ? nA : cA + (size_t)(t + 2) * kstepA; const char* b2 = last ? nB : cB + (size_t)(t + 2) * kstepB;
            const char* a3 = a2 + kstepA; const char* b3 = b2 + kstepB;
            PG8_LDB(B0, 0, 0); PG8_LDB(B1, 0, 1); PG8_SCHED; PG8_LDA(At, 0, 0); PG8_STAGE(PG8_SA(1, 1), a1 + hstepA, voffA);
            PG8_WAIT_V(8); PG8_WAIT_L(0); PG8_BAR; PG8_MMA(0, 0, At, B0); PG8_MMA(0, 1, At, B1); PG8_BAR; PG8_SCHED;
            PG8_LDA(At, 0, 1); PG8_STAGE(PG8_SB(0, 0), b2, voffB); PG8_STAGE(PG8_SB(0, 1), b2 + hstepB, voffB); PG8_STAGE(PG8_SA(0, 0), a2, voffA);
            PG8_WAIT_V(8); PG8_WAIT_L(0); PG8_BAR; PG8_MMA(1, 0, At, B0); PG8_MMA(1, 1, At, B1); PG8_BAR; PG8_SCHED;
            PG8_LDB(B0, 1, 0); PG8_LDB(B1, 1, 1); PG8_SCHED; PG8_LDA(At, 1, 0); PG8_STAGE(PG8_SA(0, 1), a2 + hstepA, voffA);
            PG8_WAIT_V(8); PG8_WAIT_L(0); PG8_BAR; PG8_MMA(0, 0, At, B0); PG8_MMA(0, 1, At, B1); PG8_BAR; PG8_SCHED;
            PG8_LDA(At, 1, 1); PG8_STAGE(PG8_SB(1, 0), b3, voffB); PG8_STAGE(PG8_SB(1, 1), b3 + hstepB, voffB); PG8_STAGE(PG8_SA(1, 0), a3, voffA);
            PG8_WAIT_V(8); PG8_WAIT_L(0); PG8_BAR; PG8_MMA(1, 0, At, B0); PG8_MMA(1, 1, At, B1); PG8_BAR; PG8_SCHED;
            if constexpr (Epi::HAS_MID) { if (t + 2 == E.tmid) { const int l2 = lane_id_v(); E.mid(acc, cur, wr, wc, l2 & 15, l2 >> 4); } }
        }
        if (wr == 0) PG8_BAR;
        { const int l2 = lane_id_v(); E(acc, cur, wr, wc, l2 & 15, l2 >> 4); }
        if (!has_next) break;
#pragma unroll
        for (int a = 0; a < 2; ++a)
#pragma unroll
            for (int b = 0; b < 2; ++b)
#pragma unroll
                for (int m = 0; m < 4; ++m)
#pragma unroll
                    for (int n = 0; n < 2; ++n) acc[a][b][m][n] = (f32x4){0.f, 0.f, 0.f, 0.f};
        cur = nxt; cA = nA; cB = nB; ++ui;
        if (wr == 1) PG8_BAR;
    }
    PG8_WAIT_V(0);
    PG8_BAR;
#undef PG8_SA
#undef PG8_SB
#undef PG8_STAGE
#undef PG8_LDA
#undef PG8_LDB
#undef PG8_MMA
#undef PG8_LD2
#undef PG8_WAIT_V
#undef PG8_WAIT_L
#undef PG8_BAR
#undef PG8_SCHED
}
typedef f32x4 Acc[2][2][4][2];

struct EpiInProj {
    static constexpr bool PERM = true, HAS_MID = false; int tmid;
    bf16_t *U, *Q, *KV, *GA, *GB;
    __device__ __forceinline__ void mid(Acc&, const GUnit&, int, int, int, int) const {}
    __device__ __forceinline__ void operator()(const Acc& acc, const GUnit& u, int wr, int wc, int fr, int fq) const {
        bf16_t* base; int ld, colt; bool sig = false; const int pn = u.pn;
        if (pn < 8) {
            const int row0 = u.pm * BM + wr * 64 + fr;
#pragma unroll
            for (int ai = 0; ai < 2; ++ai)
#pragma unroll
                for (int m = 0; m < 4; ++m) { const int r = row0 + ai * HALF + m * 16;
#pragma unroll
                    for (int bj = 0; bj < 2; ++bj) { const int c0 = pn * 256 + bj * HALF + wc * 32 + 8 * fq; const f32x4 v0 = acc[ai][bj][m][0], v1 = acc[ai][bj][m][1];
                        u32x4 w; w.x = cvt_pk_bf16(v0[0], v0[1]); w.y = cvt_pk_bf16(v0[2], v0[3]); w.z = cvt_pk_bf16(v1[0], v1[1]); w.w = cvt_pk_bf16(v1[2], v1[3]);
                        *(u32x4*)(U + ((size_t)(c0 >> 4) * 1024 + (r >> 4)) * 384 + (r & 15) * 16 + (c0 & 15)) = w; } }
            return; }
        if (pn < 16) { base = Q; ld = 2048; colt = (pn - 8) * 256; }
        else if (pn < 28) { const int t = pn - 16; base = KV + (size_t)(t >> 1) * ((size_t)M * 512); ld = 512; colt = (t & 1) * 256; }
        else {
            unsigned char* gbase = (pn < 44) ? (unsigned char*)GA : (unsigned char*)GB; const int colg = ((pn < 44) ? (pn - 28) : (pn - 44)) * 256 + wc * 32 + 8 * fq;
            const int row0 = u.pm * BM + wr * 64 + fr;
#pragma unroll
            for (int ai = 0; ai < 2; ++ai)
#pragma unroll
                for (int m = 0; m < 4; ++m) { unsigned char* rowp = gbase + (size_t)(row0 + ai * HALF + m * 16) * 4096 + colg;
#pragma unroll
                    for (int bj = 0; bj < 2; ++bj) { const f32x4 v0 = acc[ai][bj][m][0], v1 = acc[ai][bj][m][1]; unsigned q[8];
#pragma unroll
                        for (int i = 0; i < 4; ++i) { q[i] = (unsigned)fmaxf(fmaf(sigmoidf_(v0[i]), 255.f, 0.5f), 1.f); q[4 + i] = (unsigned)fmaxf(fmaf(sigmoidf_(v1[i]), 255.f, 0.5f), 1.f); }
                        u32x2 w; w.x = q[0] | (q[1] << 8) | (q[2] << 16) | (q[3] << 24); w.y = q[4] | (q[5] << 8) | (q[6] << 16) | (q[7] << 24);
                        *(u32x2*)(rowp + bj * HALF) = w; } }
            return; }
        const int row0 = u.pm * BM + wr * 64 + fr, col0 = colt + wc * 32 + 8 * fq;
#pragma unroll
        for (int ai = 0; ai < 2; ++ai)
#pragma unroll
            for (int m = 0; m < 4; ++m) { bf16_t* rowp = base + (size_t)(row0 + ai * HALF + m * 16) * ld + col0;
#pragma unroll
                for (int bj = 0; bj < 2; ++bj) { f32x4 v0 = acc[ai][bj][m][0], v1 = acc[ai][bj][m][1];
                    if (sig) {
#pragma unroll
                        for (int i = 0; i < 4; ++i) { v0[i] = sigmoidf_(v0[i]); v1[i] = sigmoidf_(v1[i]); } }
                    u32x4 w; w.x = cvt_pk_bf16(v0[0], v0[1]); w.y = cvt_pk_bf16(v0[2], v0[3]); w.z = cvt_pk_bf16(v1[0], v1[1]); w.w = cvt_pk_bf16(v1[2], v1[3]);
                    *(u32x4*)(rowp + bj * HALF) = w; } }
    }
};
struct EpiGate8 {
    static constexpr bool PERM = true, HAS_MID = false; int tmid;
    unsigned char *GA, *GB; float wscale_inv;
    __device__ __forceinline__ void mid(Acc&, const GUnit&, int, int, int, int) const {}
    __device__ __forceinline__ void operator()(const Acc& acc, const GUnit& u, int wr, int wc, int fr, int fq) const {
        unsigned char* gbase = (u.pn < 16) ? GA : GB; const int colg = (u.pn & 15) * 256 + wc * 32 + 8 * fq;
        const int row0 = u.pm * BM + wr * 64 + fr;
#pragma unroll
        for (int ai = 0; ai < 2; ++ai)
#pragma unroll
            for (int m = 0; m < 4; ++m) { unsigned char* rowp = gbase + (size_t)(row0 + ai * HALF + m * 16) * 4096 + colg;
#pragma unroll
                for (int bj = 0; bj < 2; ++bj) { const f32x4 v0 = acc[ai][bj][m][0] * wscale_inv, v1 = acc[ai][bj][m][1] * wscale_inv; unsigned q[8];
#pragma unroll
                    for (int i = 0; i < 4; ++i) { q[i] = (unsigned)fmaxf(fmaf(sigmoidf_(v0[i]), 255.f, 0.5f), 1.f); q[4 + i] = (unsigned)fmaxf(fmaf(sigmoidf_(v1[i]), 255.f, 0.5f), 1.f); }
                    u32x2 w; w.x = q[0] | (q[1] << 8) | (q[2] << 16) | (q[3] << 24); w.y = q[4] | (q[5] << 8) | (q[6] << 16) | (q[7] << 24);
                    *(u32x2*)(rowp + bj * HALF) = w; } }
    }
};
struct EpiF32Part {
    static constexpr bool PERM = false, HAS_MID = false; int tmid;
    float* dst; size_t slab_stride; int ld, ncols; int row_mul;
    __device__ __forceinline__ void mid(Acc&, const GUnit&, int, int, int, int) const {}
    __device__ __forceinline__ void operator()(const Acc& acc, const GUnit& u, int wr, int wc, int fr, int fq) const {
        float* base = dst + (size_t)u.pn * slab_stride;
        const int row0 = u.pm * row_mul + wr * 64 + fr, col0 = wc * 32 + 4 * fq;
#pragma unroll
        for (int ai = 0; ai < 2; ++ai)
#pragma unroll
            for (int m = 0; m < 4; ++m) { float* rowp = base + (size_t)(row0 + ai * HALF + m * 16) * ld + col0;
#pragma unroll
                for (int n = 0; n < 2; ++n) { if (col0 + n * 16 < ncols) *(f32x4*)(rowp + n * 16) = acc[ai][0][m][n]; } }
    }
};
struct EpiGlu {
    static constexpr bool PERM = true, HAS_MID = false; int tmid;
    const bf16_t* Y; const float* bias; bf16_t* O;
    __device__ __forceinline__ void mid(Acc&, const GUnit&, int, int, int, int) const {}
    __device__ __forceinline__ void operator()(const Acc& acc, const GUnit& u, int wr, int wc, int fr, int fq) const {
        const int row0 = u.pm * BM + wr * 64 + fr, col0 = u.pn * BM + wc * 32 + 8 * fq;
        f32x4 bv[2][2];
#pragma unroll
        for (int bj = 0; bj < 2; ++bj)
#pragma unroll
            for (int n = 0; n < 2; ++n) bv[bj][n] = *(const f32x4*)(bias + col0 + bj * HALF + 4 * n);
#pragma unroll
        for (int ai = 0; ai < 2; ++ai) {
            u32x4 yy[4][2];
#pragma unroll
            for (int m = 0; m < 4; ++m)
#pragma unroll
                for (int bj = 0; bj < 2; ++bj) yy[m][bj] = *(const u32x4*)(Y + (size_t)(row0 + ai * HALF + m * 16) * 2048 + col0 + bj * HALF);
#pragma unroll
            for (int m = 0; m < 4; ++m) { const size_t r = (size_t)(row0 + ai * HALF + m * 16);
#pragma unroll
                for (int bj = 0; bj < 2; ++bj) { const u32x4 yv = yy[m][bj];
                    const f32x4 v0 = acc[ai][bj][m][0] + bv[bj][0], v1 = acc[ai][bj][m][1] + bv[bj][1];
                    u32x4 w; w.x = cvt_pk_bf16(bf_lo(yv.x) * sigmoidf_(v0[0]), bf_hi(yv.x) * sigmoidf_(v0[1])); w.y = cvt_pk_bf16(bf_lo(yv.y) * sigmoidf_(v0[2]), bf_hi(yv.y) * sigmoidf_(v0[3]));
                    w.z = cvt_pk_bf16(bf_lo(yv.z) * sigmoidf_(v1[0]), bf_hi(yv.z) * sigmoidf_(v1[1])); w.w = cvt_pk_bf16(bf_lo(yv.w) * sigmoidf_(v1[2]), bf_hi(yv.w) * sigmoidf_(v1[3]));
                    *(u32x4*)(O + r * 4096 + col0 + bj * HALF) = w; } }
        }
    }
};
struct EpiMerge {
    static constexpr bool PERM = true, HAS_MID = true; int tmid;
    const unsigned char *GA, *GB; bf16_t* O;
    static __device__ __forceinline__ float ub(unsigned w, int i) { return (float)((w >> (8 * i)) & 0xffu); }
    __device__ __forceinline__ void mid(Acc& acc, const GUnit& u, int wr, int wc, int fr, int fq) const {
        int row0 = u.pm * BM + wr * 64 + fr, col0 = u.pn * BM + wc * 32 + 8 * fq;
        asm volatile("" : "+v"(row0), "+v"(col0));
        u32x2 ga[2][4][2], gb[2][4][2];
#pragma unroll
        for (int ai = 0; ai < 2; ++ai)
#pragma unroll
            for (int m = 0; m < 4; ++m) { const size_t r = (size_t)(row0 + ai * HALF + m * 16);
#pragma unroll
                for (int bj = 0; bj < 2; ++bj) { ga[ai][m][bj] = *(const u32x2*)(GA + r * 4096 + col0 + bj * HALF); gb[ai][m][bj] = *(const u32x2*)(GB + r * 4096 + col0 + bj * HALF); } }
#pragma unroll
        for (int ai = 0; ai < 2; ++ai)
#pragma unroll
            for (int m = 0; m < 4; ++m)
#pragma unroll
                for (int bj = 0; bj < 2; ++bj) { const u32x2 a = ga[ai][m][bj], b = gb[ai][m][bj]; f32x4 r0, r1;
#pragma unroll
                    for (int i = 0; i < 4; ++i) { r0[i] = ub(a.x, i) * __builtin_amdgcn_rcpf(ub(b.x, i)); r1[i] = ub(a.y, i) * __builtin_amdgcn_rcpf(ub(b.y, i)); }
                    acc[ai][bj][m][0] *= r0; acc[ai][bj][m][1] *= r1; }
        asm volatile("" ::: "memory");
    }
    __device__ __forceinline__ void operator()(const Acc& acc, const GUnit& u, int wr, int wc, int fr, int fq) const {
        const int row0 = u.pm * BM + wr * 64 + fr, col0 = u.pn * BM + wc * 32 + 8 * fq;
        u32x2 gb[2][4][2];
#pragma unroll
        for (int ai = 0; ai < 2; ++ai)
#pragma unroll
            for (int m = 0; m < 4; ++m)
#pragma unroll
                for (int bj = 0; bj < 2; ++bj) gb[ai][m][bj] = *(const u32x2*)(GB + (size_t)(row0 + ai * HALF + m * 16) * 4096 + col0 + bj * HALF);
        const float k255 = 1.0f / 255.0f;
#pragma unroll
        for (int ai = 0; ai < 2; ++ai)
#pragma unroll
            for (int m = 0; m < 4; ++m) { const size_t r = (size_t)(row0 + ai * HALF + m * 16);
#pragma unroll
                for (int bj = 0; bj < 2; ++bj) { const u32x2 b = gb[ai][m][bj];
                    const f32x4 v0 = acc[ai][bj][m][0] * k255, v1 = acc[ai][bj][m][1] * k255;
                    u32x4 w; w.x = cvt_pk_bf16(v0[0] * ub(b.x, 0), v0[1] * ub(b.x, 1)); w.y = cvt_pk_bf16(v0[2] * ub(b.x, 2), v0[3] * ub(b.x, 3));
                    w.z = cvt_pk_bf16(v1[0] * ub(b.y, 0), v1[1] * ub(b.y, 1)); w.w = cvt_pk_bf16(v1[2] * ub(b.y, 2), v1[3] * ub(b.y, 3));
                    *(u32x4*)(O + r * 4096 + col0 + bj * HALF) = w; } }
    }
};
struct EpiBf16SS {
    static constexpr bool PERM = true, HAS_MID = false; int tmid;
    bf16_t* C; float* SS;
    __device__ __forceinline__ void mid(Acc&, const GUnit&, int, int, int, int) const {}
    __device__ __forceinline__ void operator()(const Acc& acc, const GUnit& u, int wr, int wc, int fr, int fq) const {
        const int row0 = u.pm * BM + wr * 64 + fr, col0 = u.pn * BM + wc * 32 + 8 * fq;
#pragma unroll
        for (int ai = 0; ai < 2; ++ai)
#pragma unroll
            for (int m = 0; m < 4; ++m) { const int row = row0 + ai * HALF + m * 16; bf16_t* rowp = C + (size_t)row * 4096 + col0; float s = 0.f;
#pragma unroll
                for (int bj = 0; bj < 2; ++bj) { const f32x4 v0 = acc[ai][bj][m][0], v1 = acc[ai][bj][m][1];
                    s += ((v0[0] * v0[0] + v0[1] * v0[1]) + (v0[2] * v0[2] + v0[3] * v0[3])) + ((v1[0] * v1[0] + v1[1] * v1[1]) + (v1[2] * v1[2] + v1[3] * v1[3]));
                    u32x4 w; w.x = cvt_pk_bf16(v0[0], v0[1]); w.y = cvt_pk_bf16(v0[2], v0[3]); w.z = cvt_pk_bf16(v1[0], v1[1]); w.w = cvt_pk_bf16(v1[2], v1[3]);
                    *(u32x4*)(rowp + bj * HALF) = w; }
                s += __shfl_xor(s, 16); s += __shfl_xor(s, 32);
                if (fq == 0) SS[(size_t)row * 64 + u.pn * 4 + wc] = s; }
    }
};
struct EpiSwiGlu {
    static constexpr bool PERM = true, HAS_MID = false; int tmid;
    bf16_t* O;
    __device__ __forceinline__ void mid(Acc&, const GUnit&, int, int, int, int) const {}
    __device__ __forceinline__ void operator()(const Acc& acc, const GUnit& u, int wr, int wc, int fr, int fq) const {
        const int rl0 = wr * 64 + fr, col0 = u.pn * HALF + wc * 32 + 8 * fq;
        bf16_t* tile = O + ((size_t)u.pm * (DFF / 64) + (col0 >> 6)) * 16384 + (col0 & 63);
#pragma unroll
        for (int ai = 0; ai < 2; ++ai)
#pragma unroll
            for (int m = 0; m < 4; ++m) { const int rl = rl0 + ai * HALF + m * 16;
                const f32x4 g0 = acc[ai][0][m][0], g1 = acc[ai][0][m][1], u0 = acc[ai][1][m][0], u1 = acc[ai][1][m][1];
                float o[8];
#pragma unroll
                for (int i = 0; i < 4; ++i) { o[i] = g0[i] * sigmoidf_(g0[i]) * u0[i]; o[4 + i] = g1[i] * sigmoidf_(g1[i]) * u1[i]; }
                u32x4 w; w.x = cvt_pk_bf16(o[0], o[1]); w.y = cvt_pk_bf16(o[2], o[3]); w.z = cvt_pk_bf16(o[4], o[5]); w.w = cvt_pk_bf16(o[6], o[7]);
                *(u32x4*)(tile + rl * 64) = w; }
    }
};
}

#define XB_TMO      128
#define XB_XCNT(j)  (256  + 64 * (j))
#define XB_XSUB(j)  (1280 + 64 * (j))
#define XB_XGEN(j)  (2304 + 64 * (j))
#define XB_TOP      3328
#define XB_TOPGEN   3392
#define XCD_BAR_WORDS 3456
#define XB_SPIN_CAP (1u << 22)
__device__ __forceinline__ unsigned xb_ld(unsigned* p)              { return __hip_atomic_load(p, __ATOMIC_RELAXED, __HIP_MEMORY_SCOPE_AGENT); }
__device__ __forceinline__ unsigned xb_add(unsigned* p, unsigned v) { return __hip_atomic_fetch_add(p, v, __ATOMIC_RELAXED, __HIP_MEMORY_SCOPE_AGENT); }
__device__ __forceinline__ unsigned xb_xcc_id() { return (unsigned)__builtin_amdgcn_s_getreg((3 << 11) | 20) & 0xFu; }
#define XB_SPIN(cond, bar) do { unsigned _sp = 0; while (cond) { __builtin_amdgcn_s_sleep(1); \
    if ((++_sp & 255u) == 0u) { if (xb_ld(&(bar)[XB_TMO])) break; if (_sp > XB_SPIN_CAP) { atomicAdd(&(bar)[XB_TMO], 1u); break; } } } } while (0)
struct XcdBarrier { unsigned* bar; unsigned x; volatile LAS unsigned* st; };
__device__ __forceinline__ XcdBarrier xcd_barrier_post(unsigned* bar, volatile LAS unsigned* st) {
    XcdBarrier b; b.bar = bar; b.x = xb_xcc_id(); b.st = st;
    if (threadIdx.x == 0) (void)xb_add(&bar[XB_XCNT(b.x)], 1u);
    return b;
}
__device__ __forceinline__ void xcd_barrier_complete(unsigned* bar, unsigned x, unsigned& nloc, unsigned& nx) {
    const unsigned G = gridDim.x * gridDim.y * gridDim.z;
    unsigned sum, cnt, mine, sp = 0u;
    for (;;) {
        sum = 0u; cnt = 0u; mine = 0u;
#pragma unroll
        for (unsigned j = 0; j < 16; ++j) { const unsigned c = xb_ld(&bar[XB_XCNT(j)]); sum += c; cnt += (c > 0u) ? 1u : 0u; mine = (j == x) ? c : mine; }
        if (sum == G) break;
        __builtin_amdgcn_s_sleep(1);
        if ((++sp & 255u) == 0u) { if (xb_ld(&bar[XB_TMO])) break; if (sp > XB_SPIN_CAP) { atomicAdd(&bar[XB_TMO], 1u); break; } }
    }
    nloc = mine > 0u ? mine : 1u; nx = cnt > 0u ? cnt : 1u;
}
__device__ __forceinline__ void xcd_barrier(const XcdBarrier& b) {
    asm volatile("s_waitcnt vmcnt(0)" ::: "memory");
    __syncthreads();
    if (threadIdx.x == 0) {
        unsigned* bar = b.bar;
        __builtin_amdgcn_s_waitcnt(0);
        unsigned nloc = b.st[0], nx = b.st[1];
        if (nloc == 0u) { xcd_barrier_complete(bar, b.x, nloc, nx); b.st[0] = nloc; b.st[1] = nx; }
        const unsigned old = xb_add(&bar[XB_XSUB(b.x)], 1u);
        const unsigned gen = old / nloc;
        if (old + 1u == (gen + 1u) * nloc) {
            __builtin_amdgcn_fence(__ATOMIC_RELEASE, "agent");
            asm volatile("s_waitcnt vmcnt(0)" ::: "memory");
            const unsigned og = xb_add(&bar[XB_TOP], 1u);
            const unsigned tg = og / nx;
            if (og + 1u == (tg + 1u) * nx) xb_add(&bar[XB_TOPGEN], 1u);
            else XB_SPIN(xb_ld(&bar[XB_TOPGEN]) == tg, bar);
            __builtin_amdgcn_fence(__ATOMIC_ACQUIRE, "agent");
            xb_add(&bar[XB_XGEN(b.x)], 1u);
            asm volatile("s_waitcnt vmcnt(0)" ::: "memory");
        } else {
            XB_SPIN(xb_ld(&bar[XB_XGEN(b.x)]) == gen, bar);
            __builtin_amdgcn_fence(__ATOMIC_ACQUIRE, "agent");
            asm volatile("s_waitcnt vmcnt(0)" ::: "memory");
        }
    }
    __syncthreads();
}

struct Frame {
    LAS unsigned char* lds;
    int tid, lane, wave, vcu, G;
    const float* const* in;
    unsigned char* ws; float* out;
};
enum { I_X = 0, I_NMIXPRE, I_WIN, I_ARE, I_AIM, I_LOGDT, I_BRE, I_BIM, I_CRE, I_CIM, I_SSMD, I_WGLU, I_BGLU, I_PEK, I_W1K, I_W2K, I_PEV, I_W1V, I_W2V,
       I_WPA, I_WPB, I_WOUT, I_NMIXPOST, I_NFFNPRE, I_WGATE, I_WUP, I_WDOWN, I_NFFNPOST, N_IN };

__device__ __forceinline__ void p0_tr_item(const float* W, int N, int k0, int n_src0, bf16_t* WT, size_t ldt, int drow0, int dcol0, LAS float* scr, int lane) {
#pragma unroll 8
    for (int i = 0; i < 32; ++i) { const int kk = 2 * i + (lane >> 5); scr[kk * 33 + (lane & 31)] = W[(size_t)(k0 + kk) * N + n_src0 + (lane & 31)]; }
    LDS_WAIT(); asm volatile("" ::: "memory");
    const int c = lane & 7;
#pragma unroll
    for (int j = 0; j < 4; ++j) { const int n = (lane >> 3) + 8 * j; const LAS float* s = scr + (8 * c) * 33 + n;
        u32x4 o; o.x = pk2(s[0 * 33], s[1 * 33]); o.y = pk2(s[2 * 33], s[3 * 33]); o.z = pk2(s[4 * 33], s[5 * 33]); o.w = pk2(s[6 * 33], s[7 * 33]);
        *(GAS u32x4*)(WT + (size_t)(drow0 + n) * ldt + dcol0 + 8 * c) = o; }
    LDS_WAIT(); asm volatile("" ::: "memory");
}
__device__ __forceinline__ void p0_tr_item_fp8(const float* W, int N, int k0, int n_src0, unsigned char* WT, size_t ldt, int drow0, int dcol0, float scale, LAS float* scr, int lane) {
#pragma unroll 8
    for (int i = 0; i < 32; ++i) { const int kk = 2 * i + (lane >> 5); scr[kk * 33 + (lane & 31)] = W[(size_t)(k0 + kk) * N + n_src0 + (lane & 31)]; }
    LDS_WAIT(); asm volatile("" ::: "memory");
    const int c = lane & 7;
#pragma unroll
    for (int j = 0; j < 4; ++j) { const int n = (lane >> 3) + 8 * j; const LAS float* s = scr + (8 * c) * 33 + n;
        int w0 = __builtin_amdgcn_cvt_pk_fp8_f32(s[0 * 33] * scale, s[1 * 33] * scale, 0, false); w0 = __builtin_amdgcn_cvt_pk_fp8_f32(s[2 * 33] * scale, s[3 * 33] * scale, w0, true);
        int w1 = __builtin_amdgcn_cvt_pk_fp8_f32(s[4 * 33] * scale, s[5 * 33] * scale, 0, false); w1 = __builtin_amdgcn_cvt_pk_fp8_f32(s[6 * 33] * scale, s[7 * 33] * scale, w1, true);
        *(GAS u32x2*)(WT + (size_t)(drow0 + n) * ldt + dcol0 + 8 * c) = (u32x2){(unsigned)w0, (unsigned)w1}; }
    LDS_WAIT(); asm volatile("" ::: "memory");
}
__device__ __forceinline__ void s5_precompute_item(Frame& F, int g, int tau);
__device__ __forceinline__ void p0_side(Frame& F, int sw, int nsw) {
    for (int it = sw; it < NGRP * 17; it += nsw) s5_precompute_item(F, it / 17, it % 17);
    for (int o = sw; o < 256; o += nsw) {
        const int kv = o >> 7, n = o & 127; const float* pe = F.in[kv ? I_PEV : I_PEK]; const float* w1 = F.in[kv ? I_W1V : I_W1K];
        float s = 0.f;
        for (int k = F.lane; k < 4096; k += 64) s += pe[k] * w1[(size_t)k * 128 + n];
        s = wave_sum(s);
        if (F.lane == 0) ((float*)(F.ws + WS_CB1))[o] = s;
    }
}
__device__ __forceinline__ void p0_prologue(Frame& F) {
    LAS float* scr = (LAS float*)(F.lds + F.wave * 16384);
    const int gw = F.vcu * NWAVES + F.wave, NGW = F.G * NWAVES;
    unsigned char* ws = F.ws;
    constexpr int KB = DM / 64;
    constexpr int I_IN = KB * (7168 / 32), I_G8 = KB * (8192 / 32), I_GN = KB * (256 / 32), I_GLU = (2048 / 64) * (2048 / 32), I_PA = (2048 / 64) * (4096 / 32), I_PB = I_PA, I_OUT = KB * (4096 / 32);
    constexpr int I_G = KB * (DFF / 32), I_U = I_G, I_D = (DFF / 64) * (4096 / 32), I_W1 = 2 * KB * (128 / 32), I_W2 = 2 * 2 * 4;
    constexpr int NITEMS = I_IN + I_G8 + I_GN + I_G + I_U + I_W1 + I_W2; (void)I_D; (void)I_GLU; (void)I_PA; (void)I_PB; (void)I_OUT;
    const bool split = (NGW == 2048);
    if (split && F.wave >= 6) p0_side(F, F.vcu * 2 + (F.wave - 6), F.G * 2);
    const int tw = split ? F.vcu * 6 + F.wave : gw, TNGW = split ? F.G * 6 : NGW;
    for (int it = (split && F.wave >= 6) ? NITEMS : tw; it < NITEMS; it += TNGW) {
        int r = it;
        if (r < I_IN) { const int nb = r % 224, kb = r / 224, d0 = nb * 32; p0_tr_item(F.in[I_WIN], INW, kb * 64, d0, (bf16_t*)(ws + WS_WIN), 4096, d0, kb * 64, scr, F.lane); continue; } r -= I_IN;
        if (r < I_G8) { const int nb = r % 256, kb = r / 256, d0 = nb * 32; p0_tr_item_fp8(F.in[I_WIN], INW, kb * 64, 7216 + d0, ws + WS_WG8, 4096, d0, kb * 64, GATE_WSCALE, scr, F.lane); continue; } r -= I_G8;
        if (r < I_GN) { const int nb = r % 8, kb = r / 8; p0_tr_item(F.in[I_WIN], INW, kb * 64, 7168 + nb * 32, (bf16_t*)(ws + WS_WGN), 4096, nb * 32, kb * 64, scr, F.lane); continue; } r -= I_GN;
        if (r < I_G) { const int nb = r % 344, kb = r / 344, j = nb * 32; p0_tr_item(F.in[I_WGATE], DFF, kb * 64, j, (bf16_t*)(ws + WS_WGU), 4096, (j >> 7) * 256 + (j & 127), kb * 64, scr, F.lane); continue; } r -= I_G;
        if (r < I_U) { const int nb = r % 344, kb = r / 344, j = nb * 32; p0_tr_item(F.in[I_WUP], DFF, kb * 64, j, (bf16_t*)(ws + WS_WGU), 4096, (j >> 7) * 256 + 128 + (j & 127), kb * 64, scr, F.lane); continue; } r -= I_U;
        if (r < I_W1) { const int kv = r / (KB * 4), q = r % (KB * 4), nb = q % 4, kb = q / 4;
            const int l = kb >> 1, h = kb & 1; p0_tr_item(F.in[kv ? I_W1V : I_W1K], 128, kb * 64, nb * 32, (bf16_t*)(ws + WS_W1T) + (size_t)kv * 128 * 4096, 4096, nb * 32, h * 2048 + l * 64, scr, F.lane); continue; } r -= I_W1;
        { const int kv = r / 8, q = r % 8, nb = q % 4, kb = q / 4; p0_tr_item(F.in[kv ? I_W2V : I_W2K], 128, kb * 64, nb * 32, (bf16_t*)(ws + WS_W2T) + (size_t)kv * 128 * 128, 128, nb * 32, kb * 64, scr, F.lane); }
    }
    {
        const GAS f32x4* gn = (const GAS f32x4*)F.in[I_NMIXPRE] + F.lane;
        f32x4 va[16], vb[16];
#define HN_LOAD(V, m) do { const GAS f32x4* xr = (const GAS f32x4*)(F.in[I_X] + (size_t)(m) * DM) + F.lane; _Pragma("unroll") for (int j = 0; j < 16; ++j) V[j] = __builtin_nontemporal_load((const f32x4*)&xr[64 * j]); } while (0)
#define HN_PROC(V, m) do { float s_ = 0.f; _Pragma("unroll") for (int j = 0; j < 16; ++j) s_ += (V[j].x * V[j].x + V[j].y * V[j].y) + (V[j].z * V[j].z + V[j].w * V[j].w); \
        const float rs = 1.0f / sqrtf(wave_sum(s_) * (1.f / DM) + RMS_EPS); GAS u32x2* o8 = (GAS u32x2*)((bf16_t*)(ws + WS_HN) + (size_t)(m) * DM) + F.lane; \
        GAS unsigned* o4 = (GAS unsigned*)(ws + WS_HN8 + (size_t)(m) * DM) + F.lane; \
        _Pragma("unroll") for (int j = 0; j < 16; ++j) { const f32x4 g = gn[64 * j]; const float h0 = V[j].x * rs * g.x, h1 = V[j].y * rs * g.y, h2 = V[j].z * rs * g.z, h3 = V[j].w * rs * g.w; \
            u32x2 w; w.x = cvt_pk_bf16(h0, h1); w.y = cvt_pk_bf16(h2, h3); o8[64 * j] = w; \
            int q = __builtin_amdgcn_cvt_pk_fp8_f32(h0, h1, 0, false); q = __builtin_amdgcn_cvt_pk_fp8_f32(h2, h3, q, true); o4[64 * j] = (unsigned)q; } } while (0)
        int m = gw;
        if (m < M) HN_LOAD(va, m);
        for (; m < M; m += 2 * NGW) {
            const int m1 = m + NGW, m2 = m + 2 * NGW;
            if (m1 < M) HN_LOAD(vb, m1);
            HN_PROC(va, m);
            if (m1 < M) { if (m2 < M) HN_LOAD(va, m2); HN_PROC(vb, m1); }
        }
#undef HN_LOAD
#undef HN_PROC
    }
    if (!split) p0_side(F, gw, NGW);
}

__device__ __forceinline__ void s5_precompute_item(Frame& F, int g, int tau) {
    const int p = F.lane, gp = g * 64 + p;
    const float dt = expf(F.in[I_LOGDT][g]); const float ar = F.in[I_ARE][gp], ai = F.in[I_AIM][gp];
    const float decay = expf(dt * ar); float sn, cs; sincosf(dt * ai, &sn, &cs);
    const float abr = decay * cs, abi = decay * sn;
    const float den = ar * ar + ai * ai;
    const float zr = ((abr - 1.0f) * ar + abi * ai) / den, zi = (abi * ar - (abr - 1.0f) * ai) / den;
    float pwr = 1.f, pwi = 0.f;
    for (int k = 0; k < tau; ++k) { const float nr = pwr * abr - pwi * abi, ni = pwr * abi + pwi * abr; pwr = nr; pwi = ni; }
    bf16_t* STT = (bf16_t*)(F.ws + WS_STT) + (size_t)g * 128 * 256; bf16_t* TGT = (bf16_t*)(F.ws + WS_TGT) + (size_t)g * 256 * 384;
    if (tau == 16) { float* A16 = (float*)(F.ws + WS_SSMP); A16[gp * 2] = pwr; A16[gp * 2 + 1] = pwi; }
    float bbr[16], bbi[16];
    if (tau <= 15) {
        const float* br = F.in[I_BRE] + (size_t)gp * 16; const float* bi = F.in[I_BIM] + (size_t)gp * 16;
#pragma unroll
        for (int c = 0; c < 16; ++c) { bbr[c] = zr * br[c] - zi * bi[c]; bbi[c] = zr * bi[c] + zi * br[c]; }
        unsigned wr_[8], wi_[8];
#pragma unroll
        for (int c = 0; c < 8; ++c) { wr_[c] = pk2(pwr * bbr[2 * c] - pwi * bbi[2 * c], pwr * bbr[2 * c + 1] - pwi * bbi[2 * c + 1]); wi_[c] = pk2(pwr * bbi[2 * c] + pwi * bbr[2 * c], pwr * bbi[2 * c + 1] + pwi * bbr[2 * c + 1]); }
        const int s_ = 15 - tau;
        *(u32x4*)(STT + (size_t)p * 256 + s_ * 16) = (u32x4){wr_[0], wr_[1], wr_[2], wr_[3]}; *(u32x4*)(STT + (size_t)p * 256 + s_ * 16 + 8) = (u32x4){wr_[4], wr_[5], wr_[6], wr_[7]};
        *(u32x4*)(STT + (size_t)(64 + p) * 256 + s_ * 16) = (u32x4){wi_[0], wi_[1], wi_[2], wi_[3]}; *(u32x4*)(STT + (size_t)(64 + p) * 256 + s_ * 16 + 8) = (u32x4){wi_[4], wi_[5], wi_[6], wi_[7]};
    }
    const float* CR = F.in[I_CRE] + (size_t)g * 16 * 64 + p; const float* CI = F.in[I_CIM] + (size_t)g * 16 * 64 + p;
    float kv[16];
    const bool b5 = (p & 32) != 0, b4 = (p & 16) != 0, b3 = (p & 8) != 0, b2 = (p & 4) != 0;
#pragma unroll
    for (int c = 0; c < 16; ++c) {
        const float cr = CR[c * 64], ci = CI[c * 64];
        const float cpr = cr * pwr - ci * pwi, cpi = cr * pwi + ci * pwr;
        if (tau >= 1) { const int n = (tau - 1) * 16 + c; TGT[(size_t)n * 384 + 256 + p] = (bf16_t)f2bf(cpr); TGT[(size_t)n * 384 + 320 + p] = (bf16_t)f2bf(-cpi); }
        if (tau <= 15) {
            float v[16];
#pragma unroll
            for (int q = 0; q < 16; ++q) v[q] = cpr * bbr[q] - cpi * bbi[q];
            float w8[8], w4[4], w2[2];
#pragma unroll
            for (int j = 0; j < 8; ++j) { const float give = b5 ? v[j] : v[j + 8], keep = b5 ? v[j + 8] : v[j]; w8[j] = keep + __shfl_xor(give, 32); }
#pragma unroll
            for (int j = 0; j < 4; ++j) { const float give = b4 ? w8[j] : w8[j + 4], keep = b4 ? w8[j + 4] : w8[j]; w4[j] = keep + __shfl_xor(give, 16); }
#pragma unroll
            for (int j = 0; j < 2; ++j) { const float give = b3 ? w4[j] : w4[j + 2], keep = b3 ? w4[j + 2] : w4[j]; w2[j] = keep + __shfl_xor(give, 8); }
            float y; { const float give = b2 ? w2[0] : w2[1], keep = b2 ? w2[1] : w2[0]; y = keep + __shfl_xor(give, 4); }
            y += __shfl_xor(y, 2); y += __shfl_xor(y, 1);
            if (tau == 0 && (p >> 2) == c) y += F.in[I_SSMD][g * 16 + c];
            kv[c] = y;
        }
    }
    if (tau <= 15) {
        const int cq = p >> 2;
        for (int s_ = 0; s_ + tau < 16; ++s_) { const int t_ = s_ + tau;
            if ((p & 3) == 0) {
#pragma unroll
                for (int c = 0; c < 16; ++c) TGT[(size_t)(t_ * 16 + c) * 384 + s_ * 16 + cq] = (bf16_t)f2bf(kv[c]); }
            if (tau >= 1) {
#pragma unroll
                for (int i = 0; i < 4; ++i) { const int q = p + 64 * i; TGT[(size_t)(s_ * 16 + (q >> 4)) * 384 + t_ * 16 + (q & 15)] = (bf16_t)0; } }
        }
    }
}
__device__ __forceinline__ void s5_scan(Frame& F) {
    const int gw = F.vcu * NWAVES + F.wave, NGW = F.G * NWAVES;
    const float* HC = (const float*)(F.ws + WS_HC); const float* A16 = (const float*)(F.ws + WS_SSMP); bf16_t* UH = (bf16_t*)(F.ws + WS_UH);
    for (int task = gw; task < 512; task += NGW) {
        const int g = task >> 2, b = task & 3, p = F.lane;
        const float a_r = A16[(g * 64 + p) * 2], a_i = A16[(g * 64 + p) * 2 + 1];
        const size_t row0 = (size_t)g * 1024 + b * 256;
        float hr = 0.f, hi = 0.f;
        float era[32], eia[32], erb[32], eib[32];
#define SC_LOAD(ER, EI, k0) do { _Pragma("unroll") for (int k = 0; k < 32; ++k) { ER[k] = HC[(row0 + (k0) + k) * 128 + p]; EI[k] = HC[(row0 + (k0) + k) * 128 + 64 + p]; } } while (0)
#define SC_STEP(ER, EI, k0) do { _Pragma("unroll") for (int k = 0; k < 32; ++k) { bf16_t* up = UH + (row0 + (k0) + k) * 384 + 256 + p; up[0] = (bf16_t)f2bf(hr); up[64] = (bf16_t)f2bf(hi); \
            const float nr = a_r * hr - a_i * hi + ER[k], ni = a_r * hi + a_i * hr + EI[k]; hr = nr; hi = ni; } } while (0)
        SC_LOAD(era, eia, 0);
        for (int k0 = 0; k0 < 256; k0 += 64) {
            SC_LOAD(erb, eib, k0 + 32);
            SC_STEP(era, eia, k0);
            if (k0 + 64 < 256) SC_LOAD(era, eia, k0 + 64);
            SC_STEP(erb, eib, k0 + 32);
        }
#undef SC_LOAD
#undef SC_STEP
    }
}
struct OrdS5 {
    const char* UHb; const char* Bm; size_t bstride; int G, c;
    __device__ __forceinline__ bool next(int i, pg8::GUnit& u) const {
        const int L = i * G + c; if (L >= 512) return false;
        const int g = L >> 2;
        u.a = UHb + (size_t)L * 256 * 768; u.b = Bm + (size_t)g * bstride; u.pm = L; u.pn = 0; return true;
    }
};
namespace pg8 {
struct EpiS5Y {
    static constexpr bool PERM = true, HAS_MID = false; int tmid;
    bf16_t* Y;
    __device__ __forceinline__ void mid(Acc&, const GUnit&, int, int, int, int) const {}
    __device__ __forceinline__ void operator()(const Acc& acc, const GUnit& u, int wr, int wc, int fr, int fq) const {
        const int g = u.pm >> 2, ck0 = (u.pm & 3) * 256 + wr * 64 + fr;
#pragma unroll
        for (int ai = 0; ai < 2; ++ai)
#pragma unroll
            for (int m = 0; m < 4; ++m) { const int ck = ck0 + ai * HALF + m * 16;
#pragma unroll
                for (int bj = 0; bj < 2; ++bj) { const int n0 = bj * HALF + wc * 32 + 8 * fq; const f32x4 v0 = acc[ai][bj][m][0], v1 = acc[ai][bj][m][1];
                    u32x4 w; w.x = cvt_pk_bf16(gelu_tanh(v0[0]), gelu_tanh(v0[1])); w.y = cvt_pk_bf16(gelu_tanh(v0[2]), gelu_tanh(v0[3]));
                    w.z = cvt_pk_bf16(gelu_tanh(v1[0]), gelu_tanh(v1[1])); w.w = cvt_pk_bf16(gelu_tanh(v1[2]), gelu_tanh(v1[3]));
                    *(u32x4*)(Y + ((size_t)ck * 16 + (n0 >> 4)) * 2048 + g * 16 + (n0 & 15)) = w; } }
    }
};
}

__device__ __forceinline__ int crow(int r, int hi) { return (r & 3) + 8 * (r >> 2) + 4 * hi; }
__device__ __forceinline__ void compress2(Frame& F) {
    const float* CP = (const float*)(F.ws + WS_CP); const float* cb1 = (const float*)(F.ws + WS_CB1);
    const bf16_t* W2T = (const bf16_t*)(F.ws + WS_W2T); bf16_t* KC = (bf16_t*)(F.ws + WS_KC);
    LAS unsigned char* H = F.lds;
    const int c2off = (F.G >= 192) ? 64 : 0;
    for (int unit = F.vcu - c2off; unit >= 0 && unit < 128; unit += F.G) {
        const int R0 = unit * 64, kv = R0 >> 12;
        { const int row = F.tid >> 3, cs = (F.tid & 7) * 16;
          f32x4 a[4];
#pragma unroll
          for (int q = 0; q < 4; ++q) a[q] = *(const f32x4*)(cb1 + kv * 128 + cs + 4 * q);
#pragma unroll
          for (int s = 0; s < 8; ++s)
#pragma unroll
              for (int q = 0; q < 4; ++q) a[q] += *(const f32x4*)(CP + ((size_t)s * 8192 + R0 + row) * 128 + cs + 4 * q);
          u32x4 w0, w1;
          w0.x = pk2(gelu_tanh(a[0].x), gelu_tanh(a[0].y)); w0.y = pk2(gelu_tanh(a[0].z), gelu_tanh(a[0].w)); w0.z = pk2(gelu_tanh(a[1].x), gelu_tanh(a[1].y)); w0.w = pk2(gelu_tanh(a[1].z), gelu_tanh(a[1].w));
          w1.x = pk2(gelu_tanh(a[2].x), gelu_tanh(a[2].y)); w1.y = pk2(gelu_tanh(a[2].z), gelu_tanh(a[2].w)); w1.z = pk2(gelu_tanh(a[3].x), gelu_tanh(a[3].y)); w1.w = pk2(gelu_tanh(a[3].z), gelu_tanh(a[3].w));
          *(LAS u32x4*)(H + row * 272 + cs * 2) = w0; *(LAS u32x4*)(H + row * 272 + cs * 2 + 16) = w1; }
        __syncthreads();
        { const int rb = F.wave >> 2, cb = F.wave & 3, r32 = F.lane & 31, hi = F.lane >> 5;
          f32x16 acc = {};
#pragma unroll
          for (int k0 = 0; k0 < 8; ++k0) {
              const bf16x8 a = *(const LAS bf16x8*)(H + (rb * 32 + r32) * 272 + (k0 * 16 + hi * 8) * 2);
              const bf16x8 bq = *(const bf16x8*)(W2T + ((size_t)kv * 128 + cb * 32 + r32) * 128 + k0 * 16 + hi * 8);
              acc = __builtin_amdgcn_mfma_f32_32x32x16_bf16(a, bq, acc, 0, 0, 0); }
#pragma unroll
          for (int r = 0; r < 16; ++r) { const int R = R0 + rb * 32 + crow(r, hi); const float v = ((R & 255) == 255) ? 0.f : acc[r];
              KC[(size_t)R * 128 + cb * 32 + r32] = (bf16_t)f2bf(v); } }
        __syncthreads();
    }
}

namespace att {
constexpr float SCALE = 0.08838834764831845f, CL2 = SCALE * 1.4426950408889634f, THR = 8.f;
constexpr int KVT = 16384;
constexpr int L_K = 0, L_V = 32768, L_WS = 65536, WSB = 8192;
#define KSWZ(row, colB) ((row) * 256 + ((colB) ^ (((row) & 7) << 4)))
#define SBAR() __builtin_amdgcn_sched_barrier(0)
__device__ __forceinline__ int v_st(int k, int c) { const int kk = (k & ~0xC) | ((k & 4) << 1) | ((k & 8) >> 1); return ((kk >> 3) * 4 + (c >> 5)) * 512 + ((kk & 7) * 32 + (c & 31)) * 2; }
__device__ __forceinline__ int v_rd_base(int lane) { return ((lane & 3) << 3) | (((lane >> 2) & 3) << 6) | (((lane >> 4) & 1) << 5) | (((lane >> 5) & 1) << 8); }
constexpr int v_rd_off(int d0, int ks, int half) { return d0 * 512 + ks * 4096 + half * 2048; }
template <int OFF> __device__ __forceinline__ s16x4 tr_read(int vb) { s16x4 r; asm volatile("ds_read_b64_tr_b16 %0, %1 offset:%2" : "=&v"(r) : "v"(vb), "i"(OFF) : "memory"); return r; }
template <int D0> __device__ __forceinline__ void pv_one(f32x16& od, int vb, bf16x8 pa0, bf16x8 pa1, bf16x8 pa2, bf16x8 pa3) {
    const s16x4 l0 = tr_read<v_rd_off(D0, 0, 0)>(vb), h0 = tr_read<v_rd_off(D0, 0, 1)>(vb), l1 = tr_read<v_rd_off(D0, 1, 0)>(vb), h1 = tr_read<v_rd_off(D0, 1, 1)>(vb);
    const s16x4 l2 = tr_read<v_rd_off(D0, 2, 0)>(vb), h2 = tr_read<v_rd_off(D0, 2, 1)>(vb), l3 = tr_read<v_rd_off(D0, 3, 0)>(vb), h3 = tr_read<v_rd_off(D0, 3, 1)>(vb);
    asm volatile("s_waitcnt lgkmcnt(0)" ::: "memory"); SBAR();
#define PK(L, H) (bf16x8){L[0], L[1], L[2], L[3], H[0], H[1], H[2], H[3]}
    od = __builtin_amdgcn_mfma_f32_32x32x16_bf16(pa0, PK(l0, h0), od, 0, 0, 0);
    od = __builtin_amdgcn_mfma_f32_32x32x16_bf16(pa1, PK(l1, h1), od, 0, 0, 0);
    od = __builtin_amdgcn_mfma_f32_32x32x16_bf16(pa2, PK(l2, h2), od, 0, 0, 0);
    od = __builtin_amdgcn_mfma_f32_32x32x16_bf16(pa3, PK(l3, h3), od, 0, 0, 0);
#undef PK
}
__device__ __forceinline__ void pv_d0(f32x16* o, int vb, bf16x8 pa0, bf16x8 pa1, bf16x8 pa2, bf16x8 pa3) {
    pv_one<0>(o[0], vb, pa0, pa1, pa2, pa3); pv_one<1>(o[1], vb, pa0, pa1, pa2, pa3); pv_one<2>(o[2], vb, pa0, pa1, pa2, pa3); pv_one<3>(o[3], vb, pa0, pa1, pa2, pa3);
}
struct VFrag { s16x4 l0, h0, l1, h1, l2, h2, l3, h3; };
template <int D0> __device__ __forceinline__ void pv_rd(VFrag& f, int vb) {
    f.l0 = tr_read<v_rd_off(D0, 0, 0)>(vb); f.h0 = tr_read<v_rd_off(D0, 0, 1)>(vb); f.l1 = tr_read<v_rd_off(D0, 1, 0)>(vb); f.h1 = tr_read<v_rd_off(D0, 1, 1)>(vb);
    f.l2 = tr_read<v_rd_off(D0, 2, 0)>(vb); f.h2 = tr_read<v_rd_off(D0, 2, 1)>(vb); f.l3 = tr_read<v_rd_off(D0, 3, 0)>(vb); f.h3 = tr_read<v_rd_off(D0, 3, 1)>(vb);
}
__device__ __forceinline__ void pv_mm(f32x16& od, const VFrag& f, bf16x8 pa0, bf16x8 pa1, bf16x8 pa2, bf16x8 pa3) {
#define PK(L, H) (bf16x8){L[0], L[1], L[2], L[3], H[0], H[1], H[2], H[3]}
    od = __builtin_amdgcn_mfma_f32_32x32x16_bf16(pa0, PK(f.l0, f.h0), od, 0, 0, 0);
    od = __builtin_amdgcn_mfma_f32_32x32x16_bf16(pa1, PK(f.l1, f.h1), od, 0, 0, 0);
    od = __builtin_amdgcn_mfma_f32_32x32x16_bf16(pa2, PK(f.l2, f.h2), od, 0, 0, 0);
    od = __builtin_amdgcn_mfma_f32_32x32x16_bf16(pa3, PK(f.l3, f.h3), od, 0, 0, 0);
#undef PK
}
__device__ __forceinline__ void pv_pipe(f32x16* o, int vb, bf16x8 pa0, bf16x8 pa1, bf16x8 pa2, bf16x8 pa3) {
    VFrag fa, fb;
    asm volatile("s_waitcnt lgkmcnt(0)" ::: "memory");
    pv_rd<0>(fa, vb); pv_rd<1>(fb, vb);
    asm volatile("s_waitcnt lgkmcnt(8)" ::: "memory"); SBAR(); pv_mm(o[0], fa, pa0, pa1, pa2, pa3); SBAR();
    pv_rd<2>(fa, vb);
    asm volatile("s_waitcnt lgkmcnt(8)" ::: "memory"); SBAR(); pv_mm(o[1], fb, pa0, pa1, pa2, pa3); SBAR();
    pv_rd<3>(fb, vb);
    asm volatile("s_waitcnt lgkmcnt(8)" ::: "memory"); SBAR(); pv_mm(o[2], fa, pa0, pa1, pa2, pa3); SBAR();
    asm volatile("s_waitcnt lgkmcnt(0)" ::: "memory"); SBAR(); pv_mm(o[3], fb, pa0, pa1, pa2, pa3); SBAR();
}
__device__ __forceinline__ void qkt_pipe(f32x16& p0, f32x16& p1, LAS unsigned char* Ks, const bf16x8* qr, int r32, int hi) {
#define LDK(d0, half) (*(const LAS bf16x8*)(Ks + KSWZ((half) * 32 + r32, ((d0) * 16 + hi * 8) * 2)))
    bf16x8 f0 = LDK(0, 0), f1 = LDK(0, 1), f2 = LDK(1, 0), f3 = LDK(1, 1), f4 = LDK(2, 0), f5 = LDK(2, 1);
    SBAR();
    p0 = __builtin_amdgcn_mfma_f32_32x32x16_bf16(f0, qr[0], f32x16{}, 0, 0, 0); p1 = __builtin_amdgcn_mfma_f32_32x32x16_bf16(f1, qr[0], f32x16{}, 0, 0, 0); SBAR();
    f0 = LDK(3, 0); f1 = LDK(3, 1); SBAR();
    p0 = __builtin_amdgcn_mfma_f32_32x32x16_bf16(f2, qr[1], p0, 0, 0, 0); p1 = __builtin_amdgcn_mfma_f32_32x32x16_bf16(f3, qr[1], p1, 0, 0, 0); SBAR();
    f2 = LDK(4, 0); f3 = LDK(4, 1); SBAR();
    p0 = __builtin_amdgcn_mfma_f32_32x32x16_bf16(f4, qr[2], p0, 0, 0, 0); p1 = __builtin_amdgcn_mfma_f32_32x32x16_bf16(f5, qr[2], p1, 0, 0, 0); SBAR();
    f4 = LDK(5, 0); f5 = LDK(5, 1); SBAR();
    p0 = __builtin_amdgcn_mfma_f32_32x32x16_bf16(f0, qr[3], p0, 0, 0, 0); p1 = __builtin_amdgcn_mfma_f32_32x32x16_bf16(f1, qr[3], p1, 0, 0, 0); SBAR();
    f0 = LDK(6, 0); f1 = LDK(6, 1); SBAR();
    p0 = __builtin_amdgcn_mfma_f32_32x32x16_bf16(f2, qr[4], p0, 0, 0, 0); p1 = __builtin_amdgcn_mfma_f32_32x32x16_bf16(f3, qr[4], p1, 0, 0, 0); SBAR();
    f2 = LDK(7, 0); f3 = LDK(7, 1); SBAR();
    p0 = __builtin_amdgcn_mfma_f32_32x32x16_bf16(f4, qr[5], p0, 0, 0, 0); p1 = __builtin_amdgcn_mfma_f32_32x32x16_bf16(f5, qr[5], p1, 0, 0, 0); SBAR();
    p0 = __builtin_amdgcn_mfma_f32_32x32x16_bf16(f0, qr[6], p0, 0, 0, 0); p1 = __builtin_amdgcn_mfma_f32_32x32x16_bf16(f1, qr[6], p1, 0, 0, 0); SBAR();
    p0 = __builtin_amdgcn_mfma_f32_32x32x16_bf16(f2, qr[7], p0, 0, 0, 0); p1 = __builtin_amdgcn_mfma_f32_32x32x16_bf16(f3, qr[7], p1, 0, 0, 0); SBAR();
#undef LDK
}
__device__ __forceinline__ void qkt(f32x16& p0, f32x16& p1, LAS unsigned char* Ks, const bf16x8* qr, int r32, int hi) {
    p0 = f32x16{}; p1 = f32x16{};
#pragma unroll
    for (int d0 = 0; d0 < 8; ++d0) { const int cb = (d0 * 16 + hi * 8) * 2;
        const bf16x8 b0 = *(const LAS bf16x8*)(Ks + KSWZ(r32, cb));
        const bf16x8 b1 = *(const LAS bf16x8*)(Ks + KSWZ(32 + r32, cb));
        p0 = __builtin_amdgcn_mfma_f32_32x32x16_bf16(b0, qr[d0], p0, 0, 0, 0);
        p1 = __builtin_amdgcn_mfma_f32_32x32x16_bf16(b1, qr[d0], p1, 0, 0, 0); }
}
__device__ __forceinline__ float swap_max(float v) { auto rr = __builtin_amdgcn_permlane32_swap(__float_as_uint(v), __float_as_uint(v), false, false); return fmaxf(__uint_as_float(rr[0]), __uint_as_float(rr[1])); }
__device__ __forceinline__ float swap_sum(float v) { auto rr = __builtin_amdgcn_permlane32_swap(__float_as_uint(v), __float_as_uint(v), false, false); return __uint_as_float(rr[0]) + __uint_as_float(rr[1]); }
__device__ __forceinline__ void pack_p(const f32x16& p0, const f32x16& p1, bf16x8& pa0, bf16x8& pa1, bf16x8& pa2, bf16x8& pa3) {
#define PK4(P, BASE, OUT) do { unsigned a0 = cvt_pk_bf16(P[BASE + 0], P[BASE + 1]), a1 = cvt_pk_bf16(P[BASE + 2], P[BASE + 3]);   \
    unsigned b0 = cvt_pk_bf16(P[BASE + 4], P[BASE + 5]), b1 = cvt_pk_bf16(P[BASE + 6], P[BASE + 7]);                              \
    auto r0 = __builtin_amdgcn_permlane32_swap(a0, b0, false, false); auto r1 = __builtin_amdgcn_permlane32_swap(a1, b1, false, false); \
    u32x4 w = {r0[0], r1[0], r0[1], r1[1]}; OUT = __builtin_bit_cast(bf16x8, w); } while (0)
    PK4(p0, 0, pa0); PK4(p0, 8, pa1); PK4(p1, 0, pa2); PK4(p1, 8, pa3);
#undef PK4
}
struct Stg { bf16x8 k0, k1, v0, v1; };
template <bool WITHV> __device__ __forceinline__ void gload(Stg& s, const bf16_t* Kp, const bf16_t* Vp, size_t ld, int sr, int sc) {
    s.k0 = *(const bf16x8*)(Kp + (size_t)sr * ld + sc); s.k1 = *(const bf16x8*)(Kp + (size_t)(32 + sr) * ld + sc);
    if (WITHV) { s.v0 = *(const bf16x8*)(Vp + (size_t)sr * ld + sc); s.v1 = *(const bf16x8*)(Vp + (size_t)(32 + sr) * ld + sc); }
}
template <bool WITHV> __device__ __forceinline__ void lwrite(LAS unsigned char* lds, int buf, const Stg& s, int sr, int sc) {
    *(LAS bf16x8*)(lds + L_K + buf * KVT + KSWZ(sr, sc * 2)) = s.k0; *(LAS bf16x8*)(lds + L_K + buf * KVT + KSWZ(32 + sr, sc * 2)) = s.k1;
    if (WITHV) { *(LAS bf16x8*)(lds + L_V + buf * KVT + v_st(sr, sc)) = s.v0; *(LAS bf16x8*)(lds + L_V + buf * KVT + v_st(32 + sr, sc)) = s.v1; }
}
__device__ __forceinline__ void flash_step(f32x16& p0, f32x16& p1, float& m_reg, float& l_reg, f32x16* o, int vb, LAS float* al_l, int r32, int hi) {
    float pmax = p0[0];
#pragma unroll
    for (int r = 1; r < 16; ++r) pmax = fmaxf(pmax, p0[r]);
#pragma unroll
    for (int r = 0; r < 16; ++r) pmax = fmaxf(pmax, p1[r]);
    pmax = swap_max(pmax);
    float mn, alpha;
    if (__all(pmax - m_reg <= THR / SCALE)) { mn = m_reg; alpha = 1.f; }
    else { mn = fmaxf(m_reg, pmax); alpha = __builtin_amdgcn_exp2f((m_reg - mn) * CL2); m_reg = mn; }
    const float mnC = -mn * CL2;
    float ps = 0.f;
#pragma unroll
    for (int r = 0; r < 16; ++r) { p0[r] = __builtin_amdgcn_exp2f(fmaf(p0[r], CL2, mnC)); p1[r] = __builtin_amdgcn_exp2f(fmaf(p1[r], CL2, mnC)); ps += p0[r] + p1[r]; }
    ps = swap_sum(ps);
    l_reg = l_reg * alpha + ps;
    if (__any(alpha < 1.f)) { if (hi == 0) al_l[r32] = alpha; asm volatile("s_waitcnt lgkmcnt(0)" ::: "memory");
#pragma unroll
        for (int r = 0; r < 16; ++r) { const float a = al_l[crow(r, hi)];
#pragma unroll
            for (int d = 0; d < 4; ++d) o[d][r] *= a; } }
    bf16x8 pa0, pa1, pa2, pa3; pack_p(p0, p1, pa0, pa1, pa2, pa3);
    pv_d0(o, vb, pa0, pa1, pa2, pa3);
}

__device__ __forceinline__ void att_V(f32x16& p0, f32x16& p1, float& m_reg, float& l_reg, float& alpha, bf16x8& pa0, bf16x8& pa1, bf16x8& pa2, bf16x8& pa3, int hi, bool rowok, int mode, int lim) {
    const float NINF = -__builtin_inff();
    int limh = lim - 4 * hi; asm volatile("" : "+v"(limh));
    if (mode == 1) {
#pragma unroll
        for (int r = 0; r < 16; ++r) { const int k = ((r & 3) + 8 * (r >> 2)); if (k > limh) p0[r] = NINF; if (k + 32 > limh) p1[r] = NINF; } }
    else if (mode == 2) {
#pragma unroll
        for (int r = 0; r < 16; ++r) { const int k = ((r & 3) + 8 * (r >> 2)); if (k <= limh) p0[r] = NINF; if (k + 32 <= limh) p1[r] = NINF; } }
    float pmax = p0[0];
#pragma unroll
    for (int r = 1; r < 16; ++r) pmax = fmaxf(pmax, p0[r]);
#pragma unroll
    for (int r = 0; r < 16; ++r) pmax = fmaxf(pmax, p1[r]);
    pmax = swap_max(pmax);
    if (!rowok) pmax = NINF;
    float mn;
    if (__all(pmax - m_reg <= THR / SCALE)) { mn = m_reg; alpha = 1.f; }
    else { mn = fmaxf(m_reg, pmax); alpha = __builtin_amdgcn_exp2f((m_reg - mn) * CL2); m_reg = mn; }
    const float mnC = rowok ? -mn * CL2 : NINF;
    float s = 0.f;
#pragma unroll
    for (int r = 0; r < 16; ++r) { p0[r] = __builtin_amdgcn_exp2f(fmaf(p0[r], CL2, mnC)); p1[r] = __builtin_amdgcn_exp2f(fmaf(p1[r], CL2, mnC)); s += p0[r] + p1[r]; }
    l_reg = l_reg * alpha + swap_sum(s);
    pack_p(p0, p1, pa0, pa1, pa2, pa3);
}
__device__ __forceinline__ void att_PV(float alpha, f32x16* o, int vb, bf16x8 pa0, bf16x8 pa1, bf16x8 pa2, bf16x8 pa3, LAS float* al_l, int r32, int hi) {
    if (__any(alpha < 1.f)) { if (hi == 0) al_l[r32] = alpha; asm volatile("s_waitcnt lgkmcnt(0)" ::: "memory");
#pragma unroll
        for (int r = 0; r < 16; ++r) { const float a = al_l[crow(r, hi)];
#pragma unroll
            for (int d = 0; d < 4; ++d) o[d][r] *= a; } }
    pv_pipe(o, vb, pa0, pa1, pa2, pa3);
}

__device__ __forceinline__ float gate_val(const float* GN, int gidx, int br) {
    asm volatile("" : "+v"(gidx));
    const float* p = GN + (size_t)gidx + br * 16;
    return sigmoidf_((p[0] + p[(size_t)M * 64]) + (p[(size_t)2 * M * 64] + p[(size_t)3 * M * 64]));
}
template <int TRAIL> __device__ __forceinline__ void attn_unit(Frame& F, int b, int g, int cur) {
    const float NINF = -__builtin_inff();
    const int wid = F.wave, lane = lane_id_v(), tid = wid * 64 + lane, r32 = lane & 31, hi = lane >> 5;
    LAS unsigned char* lds = F.lds;
    LAS float* wsf = (LAS float*)(lds + L_WS + wid * WSB);
    LAS float* li_l = wsf; LAS float* al_l = wsf + 32; LAS float* impA = wsf + 64; LAS float* impE = wsf + 64 + 512; LAS unsigned* mskl = (LAS unsigned*)(wsf + 64 + 512 + 544);
    const int trel = 8 * wid + (r32 >> 2), head = r32 & 3, t0 = 64 * cur, tq = t0 + trel;
    const size_t tokq = (size_t)b * SEQ + tq;
    const bf16_t* Qb = (const bf16_t*)(F.ws + WS_Q); const bf16_t* KVb = (const bf16_t*)(F.ws + WS_KV); const bf16_t* KC = (const bf16_t*)(F.ws + WS_KC);
    const float* GN = (const float*)(F.ws + WS_GN);
    float* ACC = (float*)(F.ws + WS_ACC) + (size_t)blockIdx.x * (256 * 128);
    bf16x8 qr[8];
    { const bf16_t* Qw = Qb + tokq * 2048 + (g * 4 + head) * 128 + hi * 8;
#pragma unroll
      for (int d0 = 0; d0 < 8; ++d0) qr[d0] = *(const bf16x8*)(Qw + d0 * 16); }
    const int gidx0 = (int)(tokq * 64) + g * 4 + head;
#define GATE(br) gate_val(GN, gidx0, (br))
    const int sr0 = tid >> 4, sc0 = (tid & 15) * 8;
    const int vbase = (int)(unsigned)(uintptr_t)(lds + L_V) + v_rd_base(lane);
#define KIDX(r) (((r) & 3) + 8 * ((r) >> 2))
    f32x16 o[4]; f32x16 p0, p1; Stg stg;

#define TILE_LOOP(NT, KPTR, VPTR, LD, WITHV, ...) do { int sr = sr0, sc = sc0; asm volatile("" : "+v"(sr), "+v"(sc)); \
        { const int i = 0; gload<WITHV>(stg, KPTR, VPTR, LD, sr, sc); } lwrite<WITHV>(lds, 0, stg, sr, sc); __syncthreads(); \
        for (int i_ = 0; i_ < (NT); ++i_) { const int buf = i_ & 1; \
            if (i_ + 1 < (NT)) { const int i = i_ + 1; gload<WITHV>(stg, KPTR, VPTR, LD, sr, sc); } \
            { const int i = i_; __VA_ARGS__ } \
            if (i_ + 1 < (NT)) lwrite<WITHV>(lds, buf ^ 1, stg, sr, sc); \
            __syncthreads(); } } while (0)
#define HBAR() do { asm volatile("s_waitcnt lgkmcnt(0)" ::: "memory"); __builtin_amdgcn_s_barrier(); asm volatile("" ::: "memory"); } while (0)
#define GLK(i) do { stg.k0 = *(const bf16x8*)(KPTR_(i) + (size_t)sr * LD_ + sc); stg.k1 = *(const bf16x8*)(KPTR_(i) + (size_t)(32 + sr) * LD_ + sc); } while (0)
#define GLV(i) do { stg.k0 = *(const bf16x8*)(VPTR_(i) + (size_t)sr * LD_ + sc); stg.k1 = *(const bf16x8*)(VPTR_(i) + (size_t)(32 + sr) * LD_ + sc); } while (0)
#define WRK(buf) do { *(LAS bf16x8*)(lds + L_K + (buf) * KVT + KSWZ(sr, sc * 2)) = stg.k0; *(LAS bf16x8*)(lds + L_K + (buf) * KVT + KSWZ(32 + sr, sc * 2)) = stg.k1; } while (0)
#define WRV(buf) do { *(LAS bf16x8*)(lds + L_V + (buf) * KVT + v_st(sr, sc)) = stg.k0; *(LAS bf16x8*)(lds + L_V + (buf) * KVT + v_st(32 + sr, sc)) = stg.k1; } while (0)
#define SHIFT_LOOP_D(D, NT, MCALL, VCALL) do { int sr = sr0, sc = sc0; asm volatile("" : "+v"(sr), "+v"(sc)); const int nt_ = (NT); \
        GLK(0); stg.v0 = *(const bf16x8*)(VPTR_(0) + (size_t)sr * LD_ + sc); stg.v1 = *(const bf16x8*)(VPTR_(0) + (size_t)(32 + sr) * LD_ + sc); WRK(0); \
        *(LAS bf16x8*)(lds + L_V + v_st(sr, sc)) = stg.v0; *(LAS bf16x8*)(lds + L_V + v_st(32 + sr, sc)) = stg.v1; HBAR(); \
        for (int m_ = 0; m_ <= nt_; ++m_) { \
            if (m_ + 1 < nt_) GLK(m_ + 1); \
            if (D == 0) { const int i = m_; MCALL; } else if (m_ >= 1) { const int i = m_ - 1; VCALL; } \
            if (m_ + 1 < nt_) WRK((m_ + 1) & 1); \
            HBAR(); \
            if (m_ >= 1 && m_ < nt_) GLV(m_); \
            if (D == 0) { if (m_ < nt_) { const int i = m_; VCALL; } } else { const int i = m_; MCALL; } \
            if (m_ >= 1 && m_ < nt_) WRV(m_ & 1); \
            HBAR(); } } while (0)
#define SHIFT_LOOP(NT, MCALL, VCALL) SHIFT_LOOP_D(TRAIL, NT, MCALL, VCALL)
#define STORE_SCALED(FIRST, LAST, SCALE_ROW) do { \
        if (hi == 0) li_l[r32] = (SCALE_ROW); asm volatile("s_waitcnt lgkmcnt(0)" ::: "memory"); \
        int hh = hi, cc = r32; asm volatile("" : "+v"(hh), "+v"(cc)); \
        float* accb = ACC + (size_t)(wid * 32 + 4 * hh) * 128 + cc; \
        bf16_t* yb = (bf16_t*)(F.ws + WS_YAB) + ((size_t)b * SEQ + t0 + 8 * wid + hh) * 4096 + 2048 + g * 512 + cc; \
        _Pragma("unroll") for (int rh = 0; rh < 2; ++rh) { float prev_[8][4]; \
            if (!(FIRST)) { _Pragma("unroll") for (int r8 = 0; r8 < 8; ++r8) { const int r = rh * 8 + r8; _Pragma("unroll") for (int d0 = 0; d0 < 4; ++d0) prev_[r8][d0] = accb[((r & 3) + 8 * (r >> 2)) * 128 + d0 * 32]; } } \
            _Pragma("unroll") for (int r8 = 0; r8 < 8; ++r8) { const int r = rh * 8 + r8; const float scl = li_l[(r & 3) + 8 * (r >> 2) + 4 * hh]; \
                _Pragma("unroll") for (int d0 = 0; d0 < 4; ++d0) { float v = o[d0][r] * scl; \
                    if (!(FIRST)) v += prev_[r8][d0]; \
                    if (LAST) yb[(size_t)(2 * (r >> 2)) * 4096 + (r & 3) * 128 + d0 * 32] = (bf16_t)f2bf(v); \
                    else accb[((r & 3) + 8 * (r >> 2)) * 128 + d0 * 32] = v; } } \
            asm volatile("" ::: "memory"); } } while (0)

    const int ntc = ((4 * cur + 2) >> 6) + 1;
    const int nmax = (tq - 31) >> 4;
    const bf16_t* KCk = KC + (size_t)(b * 4 + g) * 256 * 128; const bf16_t* KCv = KCk + (size_t)16 * 256 * 128;
    float m_c = -1e30f, l_c = 0.f;
    {
        int sr = sr0, sc = sc0; asm volatile("" : "+v"(sr), "+v"(sc));
        bf16x8 ka[4], kb[4];
#pragma unroll
        for (int jt = 0; jt < 4; ++jt) if (jt < ntc) { ka[jt] = *(const bf16x8*)(KCk + (size_t)(jt * 64 + sr) * 128 + sc); kb[jt] = *(const bf16x8*)(KCk + (size_t)(jt * 64 + 32 + sr) * 128 + sc); }
#pragma unroll
        for (int jt = 0; jt < 4; ++jt) if (jt < ntc) { *(LAS bf16x8*)(lds + jt * KVT + KSWZ(sr, sc * 2)) = ka[jt]; *(LAS bf16x8*)(lds + jt * KVT + KSWZ(32 + sr, sc * 2)) = kb[jt]; }
        __syncthreads();
        for (int jt = 0; jt < ntc; ++jt) {
            qkt(p0, p1, lds + jt * KVT, qr, r32, hi);
            int lim = nmax - 64 * jt - 4 * hi; asm volatile("" : "+v"(lim));
            float pmax = NINF;
#pragma unroll
            for (int r = 0; r < 16; ++r) { if (KIDX(r) > lim) p0[r] = NINF; if (KIDX(r) + 32 > lim) p1[r] = NINF; pmax = fmaxf(pmax, fmaxf(p0[r], p1[r])); }
            pmax = swap_max(pmax);
            const float mn = fmaxf(m_c, pmax), mnC = -mn * CL2; float ps = 0.f;
#pragma unroll
            for (int r = 0; r < 16; ++r) ps += __builtin_amdgcn_exp2f(fmaf(p0[r], CL2, mnC)) + __builtin_amdgcn_exp2f(fmaf(p1[r], CL2, mnC));
            ps = swap_sum(ps);
            l_c = l_c * __builtin_amdgcn_exp2f((m_c - mn) * CL2) + ps; m_c = mn;
        }
        __syncthreads();
    }
    const float rl_c = l_c > 0.f ? 1.0f / l_c : 0.f, mcC = -m_c * CL2;
    const bool need_topk = cur >= 16;
    if (need_topk) { for (int q = lane; q < 512 + 544; q += 64) impA[q] = 0.f; }
#pragma unroll
    for (int d = 0; d < 4; ++d) o[d] = f32x16{};
    TILE_LOOP(ntc, KCk + (size_t)i * 64 * 128, KCv + (size_t)i * 64 * 128, 128, true, {
        qkt(p0, p1, lds + L_K + buf * KVT, qr, r32, hi);
        int lim = nmax - 64 * i - 4 * hi; asm volatile("" : "+v"(lim));
        _Pragma("unroll") for (int r = 0; r < 16; ++r) {
            p0[r] = (KIDX(r) > lim) ? 0.f : __builtin_amdgcn_exp2f(fmaf(p0[r], CL2, mcC)) * rl_c;
            p1[r] = (KIDX(r) + 32 > lim) ? 0.f : __builtin_amdgcn_exp2f(fmaf(p1[r], CL2, mcC)) * rl_c; }
        if (need_topk) {
            _Pragma("unroll") for (int a = 0; a < 4; ++a) {
                float s4 = (p0[4 * a] + p0[4 * a + 1]) + (p0[4 * a + 2] + p0[4 * a + 3]), e = p0[4 * a + 3];
                float s4b = (p1[4 * a] + p1[4 * a + 1]) + (p1[4 * a + 2] + p1[4 * a + 3]), eb = p1[4 * a + 3];
                s4 += __shfl_xor(s4, 1); s4 += __shfl_xor(s4, 2); e += __shfl_xor(e, 1); e += __shfl_xor(e, 2);
                s4b += __shfl_xor(s4b, 1); s4b += __shfl_xor(s4b, 2); eb += __shfl_xor(eb, 1); eb += __shfl_xor(eb, 2);
                if (head == 0) { const int j = 16 * i + 2 * a + hi, tk8 = r32 >> 2;
                    impA[tk8 * 64 + j] = s4; impE[tk8 * 68 + j + 1] = e; impA[tk8 * 64 + j + 8] = s4b; impE[tk8 * 68 + j + 9] = eb; } } }
        bf16x8 pa0, pa1, pa2, pa3; pack_p(p0, p1, pa0, pa1, pa2, pa3);
        pv_d0(o, vbase + buf * KVT, pa0, pa1, pa2, pa3);
    });
    STORE_SCALED(true, false, GATE(0));
    unsigned mlo, mhi;
    if (need_topk) {
        asm volatile("s_waitcnt lgkmcnt(0)" ::: "memory");
        LAS unsigned* keys = (LAS unsigned*)impA;
#pragma unroll
        for (int k = 0; k < 8; ++k) { const bool cand = lane >= 1 && lane <= cur - 2;
            const unsigned key = cand ? ((__float_as_uint(impA[k * 64 + lane] + impE[k * 68 + lane]) & ~63u) | (unsigned)(63 - lane)) : 0u;
            keys[k * 64 + lane] = key; }
        asm volatile("s_waitcnt lgkmcnt(0)" ::: "memory");
        const int tk = lane >> 3, s8 = lane & 7;
        const u32x4 ka = *(const LAS u32x4*)(keys + tk * 64 + s8 * 8), kb = *(const LAS u32x4*)(keys + tk * 64 + s8 * 8 + 4);
        const unsigned my[8] = {ka.x, ka.y, ka.z, ka.w, kb.x, kb.y, kb.z, kb.w};
        int cnt[8] = {0, 0, 0, 0, 0, 0, 0, 0};
#pragma unroll 4
        for (int j4 = 0; j4 < 16; ++j4) { const u32x4 x = *(const LAS u32x4*)(keys + tk * 64 + j4 * 4);
#pragma unroll
            for (int i = 0; i < 8; ++i) cnt[i] += (int)(x.x > my[i]) + (int)(x.y > my[i]) + (int)(x.z > my[i]) + (int)(x.w > my[i]); }
        unsigned byte = 0;
#pragma unroll
        for (int i = 0; i < 8; ++i) byte |= ((my[i] != 0u && cnt[i] < 13) ? 1u : 0u) << i;
        ((LAS unsigned char*)mskl)[tk * 8 + s8] = (unsigned char)byte;
        asm volatile("s_waitcnt lgkmcnt(0)" ::: "memory");
        const unsigned long long forced = 1ull | (1ull << cur) | (1ull << (cur - 1));
        mlo = mskl[2 * (r32 >> 2)] | (unsigned)forced; mhi = mskl[2 * (r32 >> 2) + 1] | (unsigned)(forced >> 32);
    } else { const unsigned long long bal = (2ull << cur) - 1ull; mlo = (unsigned)bal; mhi = (unsigned)(bal >> 32); }
    if (TRAIL) __builtin_amdgcn_s_setprio(1);
    float alpha_ = 1.f; bool act_ = false; bf16x8 pa0, pa1, pa2, pa3;
    {
        const bf16_t* Kp = KVb + (size_t)2 * M * 512 + (size_t)b * SEQ * 512 + g * 128; const bf16_t* Vp = KVb + (size_t)3 * M * 512 + (size_t)b * SEQ * 512 + g * 128;
        float m_reg = -1e30f, l_reg = 0.f;
#pragma unroll
        for (int d = 0; d < 4; ++d) o[d] = f32x16{};
#define KPTR_(i) (Kp + (size_t)(i) * 64 * 512)
#define VPTR_(i) (Vp + (size_t)(i) * 64 * 512)
#define LD_ 512
#define SELB(i) ((((i) < 32 ? (mlo >> (i)) : (mhi >> ((i) - 32))) & 1u) != 0u)
        SHIFT_LOOP(cur + 1,
            { if (i >= 1 && act_) att_PV(alpha_, o, vbase + ((i - 1) & 1) * KVT, pa0, pa1, pa2, pa3, al_l, r32, hi);
              if (i <= cur) { act_ = __any(SELB(i)); if (act_) qkt_pipe(p0, p1, lds + L_K + (i & 1) * KVT, qr, r32, hi); else { p0 = f32x16{}; p1 = f32x16{}; } } },
            { if (act_) att_V(p0, p1, m_reg, l_reg, alpha_, pa0, pa1, pa2, pa3, hi, SELB(i), (i == cur) ? 1 : 0, trel); else { pa0 = bf16x8{}; pa1 = bf16x8{}; pa2 = bf16x8{}; pa3 = bf16x8{}; } });
#undef SELB
#undef KPTR_
#undef VPTR_
        STORE_SCALED(false, false, (l_reg > 0.f ? GATE(1) / l_reg : 0.f));
    }
    {
        const bf16_t* Kp = KVb + (size_t)4 * M * 512 + (size_t)b * SEQ * 512 + g * 128; const bf16_t* Vp = KVb + (size_t)5 * M * 512 + (size_t)b * SEQ * 512 + g * 128;
        float m_reg = -1e30f, l_reg = 0.f;
        const int ntw = (cur < 8 ? cur : 8) + 1;
#pragma unroll
        for (int d = 0; d < 4; ++d) o[d] = f32x16{};
#define KPTR_(i) (Kp + (size_t)(cur - (i)) * 64 * 512)
#define VPTR_(i) (Vp + (size_t)(cur - (i)) * 64 * 512)
        SHIFT_LOOP(ntw,
            { if (i >= 1) att_PV(alpha_, o, vbase + ((i - 1) & 1) * KVT, pa0, pa1, pa2, pa3, al_l, r32, hi);
              if (i < ntw) qkt_pipe(p0, p1, lds + L_K + (i & 1) * KVT, qr, r32, hi); },
            { att_V(p0, p1, m_reg, l_reg, alpha_, pa0, pa1, pa2, pa3, hi, true, (i == 0) ? 1 : ((i == 8) ? 2 : 0), trel); });
#undef KPTR_
#undef VPTR_
#undef LD_
        if (TRAIL) __builtin_amdgcn_s_setprio(0);
        STORE_SCALED(false, true, (l_reg > 0.f ? GATE(2) / l_reg : 0.f));
    }
#undef SHIFT_LOOP
#undef SHIFT_LOOP_D
#undef HBAR
#undef GLK
#undef GLV
#undef WRK
#undef WRV
#undef TILE_LOOP
#undef STORE_SCALED
#undef GATE
#undef KIDX
}
}

__device__ __forceinline__ void row_pass1(Frame& F) {
    const int gw = F.vcu * NWAVES + F.wave, NGW = F.G * NWAVES;
    const bf16_t* O = (const bf16_t*)(F.ws + WS_O); const float* SS = (const float*)(F.ws + WS_SS1);
    const GAS f32x4* g1 = (const GAS f32x4*)F.in[I_NMIXPOST]; const GAS f32x4* g2 = (const GAS f32x4*)F.in[I_NFFNPRE];
    for (int m = gw; m < M; m += NGW) {
        const float ss = wave_sum(SS[(size_t)m * 64 + F.lane]);
        const float r1 = 1.0f / sqrtf(ss * (1.f / DM) + RMS_EPS);
        const GAS u32x2* orow = (const GAS u32x2*)(O + (size_t)m * DM) + F.lane; const GAS f32x4* xrow = (const GAS f32x4*)(F.in[I_X] + (size_t)m * DM) + F.lane;
        GAS u32x2* hrow = (GAS u32x2*)((bf16_t*)(F.ws + WS_H1B) + (size_t)m * DM) + F.lane;
        f32x4 h[16]; float s2 = 0.f;
#pragma unroll
        for (int j = 0; j < 16; ++j) { const u32x2 ob = __builtin_nontemporal_load((const u32x2*)&orow[64 * j]); const f32x4 ov = {bf_lo(ob.x), bf_hi(ob.x), bf_lo(ob.y), bf_hi(ob.y)}, xv = __builtin_nontemporal_load((const f32x4*)&xrow[64 * j]), gv = g1[64 * j + F.lane]; h[j] = xv + ov * r1 * gv; { u32x2 hw; hw.x = cvt_pk_bf16(h[j].x, h[j].y); hw.y = cvt_pk_bf16(h[j].z, h[j].w); __builtin_nontemporal_store(hw, (u32x2*)&hrow[64 * j]); }
            s2 += (h[j].x * h[j].x + h[j].y * h[j].y) + (h[j].z * h[j].z + h[j].w * h[j].w); }
        const float r2 = 1.0f / sqrtf(wave_sum(s2) * (1.f / DM) + RMS_EPS);
        GAS u32x2* o8 = (GAS u32x2*)((bf16_t*)(F.ws + WS_HN) + (size_t)m * DM) + F.lane;
#pragma unroll
        for (int j = 0; j < 16; ++j) { const f32x4 gv = g2[64 * j + F.lane]; u32x2 w; w.x = pk2(h[j].x * r2 * gv.x, h[j].y * r2 * gv.y); w.y = pk2(h[j].z * r2 * gv.z, h[j].w * r2 * gv.w); o8[64 * j] = w; }
    }
}
__device__ __forceinline__ void row_pass2(Frame& F) {
    const int gw = F.vcu * NWAVES + F.wave, NGW = F.G * NWAVES;
    const bf16_t* Fm = (const bf16_t*)(F.ws + WS_F); const float* SS = (const float*)(F.ws + WS_SS2);
    const GAS f32x4* g1 = (const GAS f32x4*)F.in[I_NFFNPOST] + F.lane;
    u32x2 fa[16], ha[16], fb[16], hb[16]; float sa, sb;
#define RP_LOAD(FB, HB, SV, m) do { const GAS u32x2* frow = (const GAS u32x2*)(Fm + (size_t)(m) * DM) + F.lane; const GAS u32x2* hrow = (const GAS u32x2*)((const bf16_t*)(F.ws + WS_H1B) + (size_t)(m) * DM) + F.lane; \
        SV = SS[(size_t)(m) * 64 + F.lane]; _Pragma("unroll") for (int j = 0; j < 16; ++j) { FB[j] = __builtin_nontemporal_load((const u32x2*)&frow[64 * j]); HB[j] = __builtin_nontemporal_load((const u32x2*)&hrow[64 * j]); } } while (0)
#define RP_PROC(FB, HB, SV, m) do { const float r1 = 1.0f / sqrtf(wave_sum(SV) * (1.f / DM) + RMS_EPS); GAS f32x4* orow = (GAS f32x4*)(F.out + (size_t)(m) * DM) + F.lane; \
        _Pragma("unroll") for (int j = 0; j < 16; ++j) { const f32x4 fv = {bf_lo(FB[j].x), bf_hi(FB[j].x), bf_lo(FB[j].y), bf_hi(FB[j].y)}, hv = {bf_lo(HB[j].x), bf_hi(HB[j].x), bf_lo(HB[j].y), bf_hi(HB[j].y)}, gv = g1[64 * j]; \
            __builtin_nontemporal_store(hv + fv * r1 * gv, (f32x4*)&orow[64 * j]); } } while (0)
    int m = gw;
    if (m < M) RP_LOAD(fa, ha, sa, m);
    for (; m < M; m += 2 * NGW) {
        const int m1 = m + NGW, m2 = m + 2 * NGW;
        if (m1 < M) RP_LOAD(fb, hb, sb, m1);
        RP_PROC(fa, ha, sa, m);
        if (m1 < M) { if (m2 < M) RP_LOAD(fa, ha, sa, m2); RP_PROC(fb, hb, sb, m1); }
    }
#undef RP_LOAD
#undef RP_PROC
}

struct OrdCmp {
    const char* KVb; const char* W1T; int G, c;
    __device__ __forceinline__ bool next(int i, pg8::GUnit& u) const {
        const int L = i * G + c; if (L >= 256) return false;
        const int slab = L & 7, pm = L >> 3, kv = pm >> 4, bg = pm & 15, b = bg >> 2, g = bg & 3, h = slab >> 2, lq = slab & 3;
        u.a = KVb + ((size_t)kv * M * 512 + (size_t)b * SEQ * 512 + g * 128 + h * 64 + (size_t)lq * 8 * 512) * 2;
        u.b = W1T + ((size_t)kv * 128 * 4096 + h * 2048 + lq * 512) * 2; u.pm = pm; u.pn = slab; return true;
    }
};

struct Args { const float* in[N_IN]; float* out; unsigned char* ws; int ph_lo, ph_hi; };
constexpr int N_PHASES = 12;
__global__ void __launch_bounds__(NWAVES * 64, 2) hybrid_fwd(Args args) {
    extern __shared__ __attribute__((aligned(16))) unsigned char lds_raw[];
    Frame F;
    F.lds = (LAS unsigned char*)lds_raw;
    F.wave = __builtin_amdgcn_readfirstlane(threadIdx.x >> 6); F.lane = lane_id_v(); F.tid = F.wave * 64 + F.lane;
    F.G = gridDim.x; { const int bx = blockIdx.x; F.vcu = (F.G % 8 == 0) ? (bx % 8) * (F.G / 8) + bx / 8 : bx; }
    F.in = args.in; F.ws = args.ws; F.out = args.out;
    unsigned char* ws = args.ws;
    for (int u = F.tid; u < (LDS_BYTES - LDSCTL_OFF) / 4; u += NWAVES * 64) ((LAS unsigned*)(F.lds + LDSCTL_OFF))[u] = 0u;
    __syncthreads();
#if MK_PER_PHASE
#define GRID_BAR() do { } while (0)
#else
    XcdBarrier bar = xcd_barrier_post((unsigned*)(ws + WS_CTL) + CW_BAR, (volatile LAS unsigned*)(F.lds + MISC_OFF) + 8);
#define GRID_BAR() xcd_barrier(bar)
#endif
    const int lo = args.ph_lo, hi = args.ph_hi;
#ifndef PH_MASK
#define PH_MASK 0xFFFF
#endif
#define IN(k) ((((PH_MASK) >> (k)) & 1) && lo <= (k) && (k) < hi)
#define BOTH(k) (IN(k) && IN((k) + 1))
    const int bx = (int)blockIdx.x;
#define REFRESH() do { F.lane = lane_id_v(); F.tid = F.wave * 64 + F.lane; } while (0)
    if (IN(0)) { REFRESH(); p0_prologue(F); if (BOTH(0)) GRID_BAR(); }
    if (IN(1)) {
        pg8::Geo g{8192, 8192, 128, 128, (size_t)128 * 8192, (size_t)128 * 8192, 64};
        pg8::OrdStd S; S.init(ws + WS_HN, ws + WS_WIN, (size_t)256 * 8192, 0, (size_t)256 * 8192, 64, 28, F.G, bx);
        pg8::EpiInProj E{0, (bf16_t*)(ws + WS_UH), (bf16_t*)(ws + WS_Q), (bf16_t*)(ws + WS_KV), (bf16_t*)(ws + WS_GA), (bf16_t*)(ws + WS_GB)};
        pg8::gemm_phase(F.lds, g, S, E);
        {
            pg8::Geo g8{4096, 4096, 128, 128, (size_t)128 * 4096, (size_t)128 * 4096, 32};
            pg8::OrdStd S8; S8.init(ws + WS_HN8, ws + WS_WG8, (size_t)256 * 4096, 0, (size_t)256 * 4096, 64, 32, F.G, bx);
            pg8::EpiGate8 E8{0, (unsigned char*)(ws + WS_GA), (unsigned char*)(ws + WS_GB), 1.0f / GATE_WSCALE};
            pg8::gemm_phase<pg8::EpiGate8, pg8::OrdStd, true>(F.lds, g8, S8, E8);
        }
        if (BOTH(1)) GRID_BAR();
    }
    if (IN(2)) {
        { pg8::Geo g{8192, 8192, 128, 128, (size_t)128 * 8192, (size_t)128 * 8192, 16};
          pg8::OrdStd S; S.init(ws + WS_HN, ws + WS_WGN, (size_t)256 * 8192, 2048, 2048, 64, 4, F.G, bx);
          pg8::EpiF32Part E{0, (float*)(ws + WS_GN), (size_t)M * 64, 64, 64, 256};
          pg8::gemm_phase(F.lds, g, S, E); }
        { pg8::Geo g{16384, 8192, 1024, 128, (size_t)128 * 16384, 0, 8};
          OrdCmp S{(const char*)(ws + WS_KV), (const char*)(ws + WS_W1T), F.G, bx};
          pg8::EpiF32Part E{0, (float*)(ws + WS_CP), (size_t)8192 * 128, 128, 128, 256};
          pg8::gemm_phase(F.lds, g, S, E); }
        { pg8::Geo g{768, 512, 128, 128, (size_t)128 * 768, 0, 4};
          OrdS5 S{(const char*)(ws + WS_UH), (const char*)(ws + WS_STT), (size_t)128 * 256 * 2, F.G, bx};
          pg8::EpiF32Part E{0, (float*)(ws + WS_HC), 0, 128, 128, 256};
          pg8::gemm_phase(F.lds, g, S, E); }
        if (BOTH(2)) GRID_BAR();
    }
    if (IN(3)) { REFRESH(); s5_scan(F); compress2(F);
        {
            const int first = (F.G >= 256) ? 64 : 0, nconv = F.G - first, myc = F.vcu - first;
            if (myc >= 0) { LAS float* scr = (LAS float*)(F.lds + F.wave * 16384);
                constexpr int J_GLU = (2048 / 64) * (2048 / 32), J_PA = (2048 / 64) * (4096 / 32), J_OUT = (4096 / 64) * (4096 / 32);
                for (int it = myc * NWAVES + F.wave; it < J_GLU + 2 * J_PA + J_OUT; it += nconv * NWAVES) { int r = it;
                    if (r < J_GLU) { const int nb = r % 64, kb = r / 64; p0_tr_item(F.in[I_WGLU], 2048, kb * 64, nb * 32, (bf16_t*)(ws + WS_WGLU), 2048, nb * 32, kb * 64, scr, F.lane); continue; } r -= J_GLU;
                    if (r < J_PA) { const int nb = r % 128, kb = r / 128; p0_tr_item(F.in[I_WPA], 4096, kb * 64, nb * 32, (bf16_t*)(ws + WS_WAB), 4096, nb * 32, kb * 64, scr, F.lane); continue; } r -= J_PA;
                    if (r < J_PA) { const int nb = r % 128, kb = r / 128; p0_tr_item(F.in[I_WPB], 4096, kb * 64, nb * 32, (bf16_t*)(ws + WS_WAB), 4096, nb * 32, 2048 + kb * 64, scr, F.lane); continue; } r -= J_PA;
                    { const int nb = r % 128, kb = r / 128; p0_tr_item(F.in[I_WOUT], 4096, kb * 64, nb * 32, (bf16_t*)(ws + WS_WOUT), 4096, nb * 32, kb * 64, scr, F.lane); } } }
        }
        if (BOTH(3)) GRID_BAR(); }
    if (IN(4)) {
        for (int k = F.vcu; k < 256; k += F.G) {
            const int bg = k >> 4, i = k & 15;
            const int curs[4] = {i, 31 - i, 32 + i, 63 - i};
#pragma unroll 1
            for (int q = 0; q < 4; ++q) { const int cur = (q == 0) ? 63 - i : (q == 1) ? 32 + i : (q == 2) ? 31 - i : i;
                if (F.wave < 4) att::attn_unit<0>(F, bg >> 2, bg & 3, cur); else att::attn_unit<1>(F, bg >> 2, bg & 3, cur); }
            (void)curs;
        }
        { pg8::Geo g{768, 768, 128, 128, (size_t)128 * 768, (size_t)128 * 768, 6};
          OrdS5 S{(const char*)(ws + WS_UH), (const char*)(ws + WS_TGT), (size_t)256 * 384 * 2, F.G, bx};
          pg8::EpiS5Y E{0, (bf16_t*)(ws + WS_Y)};
          pg8::gemm_phase(F.lds, g, S, E); }
        if (BOTH(4)) GRID_BAR();
    }
    if (IN(5)) {
        pg8::Geo g{4096, 4096, 128, 128, (size_t)128 * 4096, (size_t)128 * 4096, 32};
        pg8::OrdStd S; S.init(ws + WS_Y, ws + WS_WGLU, (size_t)256 * 4096, 0, (size_t)256 * 4096, 64, 8, F.G, bx);
        pg8::EpiGlu E{0, (const bf16_t*)(ws + WS_Y), F.in[I_BGLU], (bf16_t*)(ws + WS_YAB)};
        pg8::gemm_phase(F.lds, g, S, E);
        if (BOTH(5)) GRID_BAR();
    }
    if (IN(6)) {
        pg8::Geo g{8192, 8192, 128, 128, (size_t)128 * 8192, (size_t)128 * 8192, 64};
        pg8::OrdStd S; S.init(ws + WS_YAB, ws + WS_WAB, (size_t)256 * 8192, 0, (size_t)256 * 8192, 64, 16, F.G, bx);
        pg8::EpiMerge E{32, (const unsigned char*)(ws + WS_GA), (const unsigned char*)(ws + WS_GB), (bf16_t*)(ws + WS_MRG)};
        pg8::gemm_phase(F.lds, g, S, E);
        if (BOTH(6)) GRID_BAR();
    }
    if (IN(7)) {
        pg8::Geo g{8192, 8192, 128, 128, (size_t)128 * 8192, (size_t)128 * 8192, 64};
        pg8::OrdStd S; S.init(ws + WS_MRG, ws + WS_WOUT, (size_t)256 * 8192, 0, (size_t)256 * 8192, 64, 16, F.G, bx);
        pg8::EpiBf16SS E{0, (bf16_t*)(ws + WS_O), (float*)(ws + WS_SS1)};
        pg8::gemm_phase(F.lds, g, S, E);
        if (BOTH(7)) GRID_BAR();
    }
    if (IN(8)) { REFRESH(); row_pass1(F); if (BOTH(8)) GRID_BAR(); }
    if (IN(9)) {
        pg8::Geo g{8192, 8192, 128, 128, (size_t)128 * 8192, (size_t)128 * 8192, 64};
        pg8::OrdStd S; S.init(ws + WS_HN, ws + WS_WGU, (size_t)256 * 8192, 0, (size_t)256 * 8192, 64, 86, F.G, bx);
        pg8::EpiSwiGlu E{0, (bf16_t*)(ws + WS_A2)};
        pg8::gemm_phase(F.lds, g, S, E);
        {
            const int nun = 64 * 86, rounds = (nun + F.G - 1) / F.G, first_idle = nun - (rounds - 1) * F.G;
            const int nconv = (first_idle < F.G) ? F.G - first_idle : F.G, myc = (first_idle < F.G) ? bx - first_idle : bx;
            if (myc >= 0) { REFRESH(); LAS float* scr = (LAS float*)(F.lds + F.wave * 16384);
                for (int it = myc * NWAVES + F.wave; it < (DFF / 64) * 128; it += nconv * NWAVES) { const int nb = it % 128, kb = it / 128;
                    p0_tr_item(F.in[I_WDOWN], 4096, kb * 64, nb * 32, (bf16_t*)(ws + WS_WDN) + ((size_t)(nb >> 3) * (DFF / 64) + kb) * 16384, 64, (nb & 7) * 32, 0, scr, F.lane); } }
        }
        if (BOTH(9)) GRID_BAR();
    }
    if (IN(10)) {
        pg8::Geo g{128, 128, 32768, 32768, 16384, 16384, DFF / 64};
        pg8::OrdStd S; S.init(ws + WS_A2, ws + WS_WDN, (size_t)(DFF / 64) * 32768, 0, (size_t)(DFF / 64) * 32768, 64, 16, F.G, bx, 4);
        pg8::EpiBf16SS E{0, (bf16_t*)(ws + WS_F), (float*)(ws + WS_SS2)};
        pg8::gemm_phase(F.lds, g, S, E);
        if (BOTH(10)) GRID_BAR();
    }
    if (IN(11)) { REFRESH(); row_pass2(F); }
#undef IN
#undef BOTH
}

extern "C" void kernel_launch(void* const* d_in, const int* in_sizes, int n_in, void* d_out, int out_size, void* d_ws, size_t ws_size, hipStream_t stream) {
    static int grid = 0;
    if (grid == 0) {
        if (n_in != N_IN || in_sizes[0] != M * DM || out_size != M * DM || ws_size < WS_END) {
            fprintf(stderr, "kernel_launch: shape mismatch: n_in %d in0 %d out %d ws %zu (need %zu)\n", n_in, n_in > 0 ? in_sizes[0] : -1, out_size, ws_size, (size_t)WS_END); grid = -1; return; }
        int dev = 0, cus = 0, per_cu = 0;
        if (hipGetDevice(&dev) != hipSuccess || hipDeviceGetAttribute(&cus, hipDeviceAttributeMultiprocessorCount, dev) != hipSuccess) { grid = -1; return; }
        if (hipFuncSetAttribute((const void*)hybrid_fwd, hipFuncAttributeMaxDynamicSharedMemorySize, LDS_BYTES) != hipSuccess) { fprintf(stderr, "kernel_launch: hipFuncSetAttribute failed\n"); grid = -1; return; }
        if (hipOccupancyMaxActiveBlocksPerMultiprocessor(&per_cu, (const void*)hybrid_fwd, NWAVES * 64, LDS_BYTES) != hipSuccess || per_cu < 1)
            fprintf(stderr, "kernel_launch: occupancy query reports %d workgroups per CU\n", per_cu);
        (void)hipGetLastError();
        grid = cus;
    }
    if (grid < 0) return;
    if (hipMemsetAsync((char*)d_ws + WS_CTL, 0, CTL_ZERO_BYTES, stream) != hipSuccess) { fprintf(stderr, "kernel_launch: memset failed\n"); return; }
    Args a{};
    for (int i = 0; i < N_IN; ++i) a.in[i] = (const float*)d_in[i];
    a.out = (float*)d_out; a.ws = (unsigned char*)d_ws;
#if MK_PER_PHASE
#ifndef PROBE_REP_MASK
#define PROBE_REP_MASK 0
#endif
#ifndef PROBE_REPS
#define PROBE_REPS 1
#endif
    for (int p = 0; p < N_PHASES; ++p) { a.ph_lo = p; a.ph_hi = p + 1; const int reps = 1 + (((PROBE_REP_MASK) >> p) & 1) * (PROBE_REPS);
        for (int r = 0; r < reps; ++r) hipLaunchKernelGGL(hybrid_fwd, dim3(grid), dim3(NWAVES * 64), LDS_BYTES, stream, a); }
#else
    a.ph_lo = 0; a.ph_hi = N_PHASES; hipLaunchKernelGGL(hybrid_fwd, dim3(grid), dim3(NWAVES * 64), LDS_BYTES, stream, a);
#endif
    const hipError_t le = hipPeekAtLastError();
    if (le != hipSuccess) fprintf(stderr, "kernel_launch: launch failed: %s\n", hipGetErrorName(le));
}
```

```cpp
#include <hip/hip_runtime.h>
#include <cstdio>
#include <cstdint>

#ifndef MK_PER_PHASE
#define MK_PER_PHASE 0
#endif

#define LAS __attribute__((address_space(3)))
#define GAS __attribute__((address_space(1)))
typedef unsigned short bf16_t;
typedef short bf16x8 __attribute__((ext_vector_type(8)));
typedef short s16x4 __attribute__((ext_vector_type(4)));
typedef float f32x4 __attribute__((ext_vector_type(4)));
typedef float f32x2 __attribute__((ext_vector_type(2)));
typedef float f32x16 __attribute__((ext_vector_type(16)));
typedef unsigned u32x4 __attribute__((ext_vector_type(4)));
typedef unsigned u32x2 __attribute__((ext_vector_type(2)));
typedef GAS unsigned gu32;

constexpr int DM = 4096, BATCH = 4, SEQ = 4096, M = BATCH * SEQ;
constexpr int SSMW = 2048, NGRP = 128, GC = 16, NST = 64;
constexpr int NH = 16, HD = 128, NKV = 4, HPG = 4, ATTW = 2048, KVW = 512;
constexpr int DFF = 11008;
constexpr int INW = 15408;
constexpr int NCMP = 255;
constexpr float RMS_EPS = 1e-6f;

constexpr size_t MiB = 1u << 20;
constexpr size_t WS_CTL = 0, CTL_ZERO_BYTES = 32768;
constexpr size_t WS_SSMP = 1 * MiB;
constexpr size_t WS_CB1 = 3 * MiB;
constexpr size_t WS_W1T = 4 * MiB;
constexpr size_t WS_W2T = 6 * MiB;
constexpr size_t WS_KC = 7 * MiB;
constexpr size_t WS_WGN = 9 * MiB;
constexpr size_t WS_STT = 12 * MiB;
constexpr size_t WS_TGT = 20 * MiB;
constexpr size_t WS_GN = 44 * MiB;
constexpr size_t WS_WGLU = 60 * MiB;
constexpr size_t WS_WAB = 68 * MiB;
constexpr size_t WS_WOUT = 100 * MiB;
constexpr size_t WS_WDN = 132 * MiB;
constexpr size_t WS_WGU = 218 * MiB;
constexpr size_t WS_R1 = 390 * MiB;
constexpr size_t WS_R2 = 518 * MiB;
constexpr size_t WS_R3 = 646 * MiB;
constexpr size_t WS_UH = WS_R3;
constexpr size_t WS_Q = WS_UH + 96 * MiB;
constexpr size_t WS_KV = WS_Q + 64 * MiB;
constexpr size_t WS_GA = WS_KV + 96 * MiB;
constexpr size_t WS_GB = WS_GA + 128 * MiB;
constexpr size_t WS_END = WS_GB + 128 * MiB;
constexpr size_t WS_WIN = WS_R1, WS_YAB = WS_R1, WS_F = WS_R1;
constexpr size_t WS_WG8 = WS_R1 + 56 * MiB;
constexpr size_t WS_HN8 = WS_GB + 64 * MiB;
constexpr float GATE_WSCALE = 128.f;
constexpr size_t WS_HC = WS_R1;
constexpr size_t WS_CP = WS_R1 + 64 * MiB;
constexpr size_t WS_HN = WS_R2;
constexpr size_t WS_Y = WS_R2;
constexpr size_t WS_ACC = WS_R2 + 64 * MiB;
constexpr size_t WS_MRG = WS_Q;
constexpr size_t WS_O = WS_GA;
constexpr size_t WS_A2 = WS_R3;
constexpr size_t WS_SS1 = WS_UH;
constexpr size_t WS_SS2 = WS_R3 + 344 * MiB;
constexpr size_t WS_H1B = WS_GA + 128 * MiB;
static_assert(WS_A2 + (size_t)M * DFF * 2 <= WS_SS2 && WS_SS2 + 4 * MiB <= WS_H1B && WS_O + 128 * MiB <= WS_H1B && WS_H1B + 128 * MiB <= WS_END, "a | ss2 | h1b fit");
static_assert(WS_WGU + (size_t)22016 * 4096 * 2 <= WS_R1, "wgu fits");
static_assert(WS_WDN + (size_t)4096 * 11008 * 2 <= WS_WGU, "wdn fits");

constexpr int CW_TMO = 0;
constexpr int CW_BAR = 4096;

constexpr int RING_BYTES = 131072;
constexpr int LDSCTL_OFF = RING_BYTES, MISC_OFF = LDSCTL_OFF + 320;
constexpr int LDS_BYTES = 147456;
constexpr int NWAVES = 8;

__device__ __forceinline__ unsigned cvt_pk_bf16(float lo, float hi) { unsigned r; asm volatile("v_cvt_pk_bf16_f32 %0, %1, %2" : "=v"(r) : "v"(lo), "v"(hi)); return r; }
__device__ __forceinline__ unsigned f2bf(float f) { unsigned u = __builtin_bit_cast(unsigned, f); return (u + 0x7fffu + ((u >> 16) & 1u)) >> 16; }
__device__ __forceinline__ unsigned pk2(float lo, float hi) { return f2bf(lo) | (f2bf(hi) << 16); }
__device__ __forceinline__ float bf_lo(unsigned w) { return __builtin_bit_cast(float, w << 16); }
__device__ __forceinline__ float bf_hi(unsigned w) { return __builtin_bit_cast(float, w & 0xffff0000u); }
__device__ __forceinline__ float sigmoidf_(float x) { return __builtin_amdgcn_rcpf(1.0f + __builtin_amdgcn_exp2f(-1.4426950408889634f * x)); }
__device__ __forceinline__ float gelu_tanh(float x) { const float u = 1.5957691216057308f * (x + 0.044715f * x * x * x); return x * sigmoidf_(u); }
__device__ __forceinline__ float wave_sum(float v) {
#pragma unroll
    for (int o = 1; o < 64; o <<= 1) v += __shfl_xor(v, o);
    return v;
}
__device__ __forceinline__ int lane_id_v() { int l; asm volatile("v_mbcnt_lo_u32_b32 %0, -1, 0\n\tv_mbcnt_hi_u32_b32 %0, -1, %0" : "=v"(l)); return l; }
#define LDS_WAIT() asm volatile("s_waitcnt lgkmcnt(0)" ::: "memory")
#define VM_WAIT() asm volatile("s_waitcnt vmcnt(0)" ::: "memory")

namespace pg8 {
constexpr int BM = 256, BK = 64, HALF = 128, HTB = HALF * BK * 2, STAGE_BYTES = 8 * HTB, NXCD = 8, WGM = 8;
__host__ __device__ __forceinline__ int lds_byte(int r, int c) { const int st = (r >> 4) * 2 + (c >> 5), rr = r & 15, cc = c & 31, ob = rr * 64 + cc * 2; return st * 1024 + (ob ^ (((ob >> 9) & 1) << 5)); }
__host__ __device__ __forceinline__ void stage_rc(int b, int& R, int& C) { const int st = b / 1024, sb = b % 1024, swz = sb ^ (((sb >> 9) & 1) << 5); R = (st >> 1) * 16 + swz / 64; C = (st & 1) * 32 + (swz % 64) / 2; }
__host__ __device__ __forceinline__ int perm32(int rho) { const int n = rho >> 4, i = rho & 15; return 8 * (i >> 2) + 4 * n + (i & 3); }

struct GUnit { const char* a; const char* b; int pm, pn; };
struct Geo { size_t rsA, rsB, kstepA, kstepB, hstepA, hstepB; int nt; };

struct OrdStd {
    const char* A; const char* B; size_t amul, apn, bpn; int nM, nN, nwg, G, c, wgm;
    __device__ __forceinline__ void init(const void* A_, const void* B_, size_t amul_, size_t apn_, size_t bpn_, int nM_, int nN_, int G_, int c_, int wgm_ = WGM) {
        A = (const char*)A_; B = (const char*)B_; amul = amul_; apn = apn_; bpn = bpn_; nM = nM_; nN = nN_; nwg = nM * nN; G = G_; c = c_; wgm = wgm_; }
    __device__ __forceinline__ bool next(int i, GUnit& u) const {
        const long L = (long)i * G + c; if (L >= nwg) return false;
        int wgid = (int)L; { const int q = nwg / NXCD, r = nwg % NXCD, xcd = wgid % NXCD, off = wgid / NXCD; wgid = (xcd < r ? xcd * (q + 1) : r * (q + 1) + (xcd - r) * q) + off; }
        const int nig = wgm * nN, gid = wgid / nig, fm = gid * wgm, gsz = (nM - fm) < wgm ? (nM - fm) : wgm;
        u.pm = fm + ((wgid % nig) % gsz); u.pn = (wgid % nig) / gsz;
        u.a = A + (size_t)u.pm * amul + (size_t)u.pn * apn; u.b = B + (size_t)u.pn * bpn; return true;
    }
};

__device__ __forceinline__ void glds16_s(const void* sbase, unsigned voff, unsigned lds_dst) {
    unsigned keep;
    asm volatile("s_mov_b32 %0, m0\n\ts_mov_b32 m0, %3\n\ts_nop 0\n\tglobal_load_lds_dwordx4 %1, %2\n\ts_mov_b32 m0, %0" : "=&s"(keep) : "v"(voff), "s"(sbase), "s"(lds_dst) : "memory");
}
typedef int v8i_t __attribute__((ext_vector_type(8)));
typedef int i32x4_t __attribute__((ext_vector_type(4)));
template <class Epi, class Sched, bool FP8 = false>
__device__ __forceinline__ void gemm_phase(LAS unsigned char* lds, const Geo g, const Sched& S, const Epi& E) {
    const int lane = lane_id_v(), wid = __builtin_amdgcn_readfirstlane(threadIdx.x >> 6), tid = wid * 64 + lane, wr = wid >> 2, wc = wid & 3, fr = lane & 15, fq = lane >> 4;
    const int nt = g.nt;
    unsigned voffA[2], voffB[2];
#pragma unroll
    for (int i = 0; i < 2; ++i) { int R, C; stage_rc(tid * 16 + i * 8192, R, C); const int Rb = Epi::PERM ? ((R & ~31) + perm32(R & 31)) : R;
        voffA[i] = (unsigned)((size_t)R * g.rsA + (size_t)C * 2u); voffB[i] = (unsigned)((size_t)Rb * g.rsB + (size_t)C * 2u); }
    const size_t kstepA = g.kstepA, kstepB = g.kstepB, hstepA = g.hstepA, hstepB = g.hstepB;
    const unsigned ldsw = (unsigned)wid * 1024u;
    const int aoff = lds_byte(wr * 64 + fr, fq * 8), boff = lds_byte(wc * 32 + fr, fq * 8);
#define PG8_SA(b, h) (((b) * 2 + (h)) * HTB)
#define PG8_SB(b, h) ((4 + (b) * 2 + (h)) * HTB)
#define PG8_STAGE(bufoff, gbase, voff) do { _Pragma("unroll") for (int _i = 0; _i < 2; ++_i) { \
        if constexpr (FP8) glds16_s((const void*)(gbase), (voff)[_i], (unsigned)(uintptr_t)(lds + (bufoff) + ldsw + _i * 8192)); \
        else __builtin_amdgcn_global_load_lds((const unsigned*)((const char*)(gbase) + (voff)[_i]), (LAS unsigned*)(lds + (bufoff) + ldsw + _i * 8192), 16, 0, 0); } } while (0)
#define PG8_LD2(base) __builtin_shufflevector(*(const LAS i32x4_t*)(base), *(const LAS i32x4_t*)((base) + 1024), 0, 1, 2, 3, 4, 5, 6, 7)
#define PG8_LDA(dst, b, h) do { if constexpr (FP8) { _Pragma("unroll") for (int m = 0; m < 4; ++m) dst##8[m] = PG8_LD2(lds + PG8_SA(b, h) + aoff + m * 2048); } \
        else { _Pragma("unroll") for (int m = 0; m < 4; ++m) _Pragma("unroll") for (int k = 0; k < 2; ++k) dst[m][k] = *(const LAS bf16x8*)(lds + PG8_SA(b, h) + aoff + m * 2048 + k * 1024); } } while (0)
#define PG8_LDB(dst, b, h) do { if constexpr (FP8) { _Pragma("unroll") for (int n = 0; n < 2; ++n) dst##8[n] = PG8_LD2(lds + PG8_SB(b, h) + boff + n * 2048); } \
        else { _Pragma("unroll") for (int n = 0; n < 2; ++n) _Pragma("unroll") for (int k = 0; k < 2; ++k) dst[n][k] = *(const LAS bf16x8*)(lds + PG8_SB(b, h) + boff + n * 2048 + k * 1024); } } while (0)
#define PG8_MMA(ai, bj, At, Bt) do { __builtin_amdgcn_s_setprio(1); \
        if constexpr (FP8) { _Pragma("unroll") for (int m = 0; m < 4; ++m) _Pragma("unroll") for (int n = 0; n < 2; ++n) \
            acc[ai][bj][m][n] = __builtin_amdgcn_mfma_scale_f32_16x16x128_f8f6f4(Bt##8[n], At##8[m], acc[ai][bj][m][n], 0, 0, 0, 0x7f7f7f7f, 0, 0x7f7f7f7f); } \
        else { _Pragma("unroll") for (int m = 0; m < 4; ++m) _Pragma("unroll") for (int n = 0; n < 2; ++n) _Pragma("unroll") for (int k = 0; k < 2; ++k) \
            acc[ai][bj][m][n] = __builtin_amdgcn_mfma_f32_16x16x32_bf16(Bt[n][k], At[m][k], acc[ai][bj][m][n], 0, 0, 0); } \
        __builtin_amdgcn_s_setprio(0); } while (0)
#define PG8_WAIT_V(n) asm volatile("s_waitcnt vmcnt(" #n ")" ::: "memory")
#define PG8_WAIT_L(n) asm volatile("s_waitcnt lgkmcnt(" #n ")" ::: "memory")
#define PG8_BAR __builtin_amdgcn_s_barrier()
#define PG8_SCHED __builtin_amdgcn_sched_barrier(0)
    GUnit cur, nxt; int ui = 0;
    if (!S.next(0, cur)) return;
    f32x4 acc[2][2][4][2];
#pragma unroll
    for (int a = 0; a < 2; ++a)
#pragma unroll
        for (int b = 0; b < 2; ++b)
#pragma unroll
            for (int m = 0; m < 4; ++m)
#pragma unroll
                for (int n = 0; n < 2; ++n) acc[a][b][m][n] = (f32x4){0.f, 0.f, 0.f, 0.f};
    bf16x8 At[4][2], B0[2][2], B1[2][2];
    v8i_t At8[4], B08[2], B18[2];
    const char* cA = cur.a; const char* cB = cur.b;
    PG8_STAGE(PG8_SB(0, 0), cB, voffB); PG8_STAGE(PG8_SB(0, 1), cB + hstepB, voffB); PG8_STAGE(PG8_SA(0, 0), cA, voffA); PG8_STAGE(PG8_SA(0, 1), cA + hstepA, voffA);
    if (wr == 1) PG8_BAR;
    PG8_WAIT_V(2); PG8_BAR;
    PG8_STAGE(PG8_SB(1, 0), cB + kstepB, voffB); PG8_STAGE(PG8_SA(1, 0), cA + kstepA, voffA); PG8_STAGE(PG8_SB(1, 1), cB + hstepB + kstepB, voffB);
    PG8_WAIT_V(6); PG8_BAR;
    for (;;) {
        const bool has_next = S.next(ui + 1, nxt);
        const char* nA = has_next ? nxt.a : cA; const char* nB = has_next ? nxt.b : cB;
        for (int t = 0; t < nt; t += 2) {
            const bool last = (t == nt - 2);
            const char* a1 = cA + (size_t)(t + 1) * kstepA;
            const char* a2 = last ? nA : cA + (size_t)(t + 2) * kstepA; const char* b2 = last ? nB : cB + (size_t)(t + 2) * kstepB;
            const char* a3 = a2 + kstepA; const char* b3 = b2 + kstepB;
            PG8_LDB(B0, 0, 0); PG8_LDB(B1, 0, 1); PG8_SCHED; PG8_LDA(At, 0, 0); PG8_STAGE(PG8_SA(1, 1), a1 + hstepA, voffA);
            PG8_WAIT_V(8); PG8_WAIT_L(0); PG8_BAR; PG8_MMA(0, 0, At, B0); PG8_MMA(0, 1, At, B1); PG8_BAR; PG8_SCHED;
            PG8_LDA(At, 0, 1); PG8_STAGE(PG8_SB(0, 0), b2, voffB); PG8_STAGE(PG8_SB(0, 1), b2 + hstepB, voffB); PG8_STAGE(PG8_SA(0, 0), a2, voffA);
            PG8_WAIT_V(8); PG8_WAIT_L(0); PG8_BAR; PG8_MMA(1, 0, At, B0); PG8_MMA(1, 1, At, B1); PG8_BAR; PG8_SCHED;
            PG8_LDB(B0, 1, 0); PG8_LDB(B1, 1, 1); PG8_SCHED; PG8_LDA(At, 1, 0); PG8_STAGE(PG8_SA(0, 1), a2 + hstepA, voffA);
            PG8_WAIT_V(8); PG8_WAIT_L(0); PG8_BAR; PG8_MMA(0, 0, At, B0); PG8_MMA(0, 1, At, B1); PG8_BAR; PG8_SCHED;
            PG8_LDA(At, 1, 1); PG8_STAGE(PG8_SB(1, 0), b3, voffB); PG8_STAGE(PG8_SB(1, 1), b3 + hstepB, voffB); PG8_STAGE(PG8_SA(1, 0), a3, voffA);
            PG8_WAIT_V(8); PG8_WAIT_L(0); PG8_BAR; PG8_MMA(1, 0, At, B0); PG8_MMA(1, 1, At, B1); PG8_BAR; PG8_SCHED;
            if constexpr (Epi::HAS_MID) { if (t + 2 == E.tmid) { const int l2 = lane_id_v(); E.mid(acc, cur, wr, wc, l2 & 15, l2 >> 4); } }
        }
        if (wr == 0) PG8_BAR;
        { const int l2 = lane_id_v(); E(acc, cur, wr, wc, l2 & 15, l2 >> 4); }
        if (!has_next) break;
#pragma unroll
        for (int a = 0; a < 2; ++a)
#pragma unroll
            for (int b = 0; b < 2; ++b)
#pragma unroll
                for (int m = 0; m < 4; ++m)
#pragma unroll
                    for (int n = 0; n < 2; ++n) acc[a][b][m][n] = (f32x4){0.f, 0.f, 0.f, 0.f};
        cur = nxt; cA = nA; cB = nB; ++ui;
        if (wr == 1) PG8_BAR;
    }
    PG8_WAIT_V(0);
    PG8_BAR;
#undef PG8_SA
#undef PG8_SB
#undef PG8_STAGE
#undef PG8_LDA
#undef PG8_LDB
#undef PG8_MMA
#undef PG8_LD2
#undef PG8_WAIT_V
#undef PG8_WAIT_L
#undef PG8_BAR
#undef PG8_SCHED
}
typedef f32x4 Acc[2][2][4][2];

struct EpiInProj {
    static constexpr bool PERM = true, HAS_MID = false; int tmid;
    bf16_t *U, *Q, *KV, *GA, *GB;
    __device__ __forceinline__ void mid(Acc&, const GUnit&, int, int, int, int) const {}
    __device__ __forceinline__ void operator()(const Acc& acc, const GUnit& u, int wr, int wc, int fr, int fq) const {
        bf16_t* base; int ld, colt; bool sig = false; const int pn = u.pn;
        if (pn < 8) {
            const int row0 = u.pm * BM + wr * 64 + fr;
#pragma unroll
            for (int ai = 0; ai < 2; ++ai)
#pragma unroll
                for (int m = 0; m < 4; ++m) { const int r = row0 + ai * HALF + m * 16;
#pragma unroll
                    for (int bj = 0; bj < 2; ++bj) { const int c0 = pn * 256 + bj * HALF + wc * 32 + 8 * fq; const f32x4 v0 = acc[ai][bj][m][0], v1 = acc[ai][bj][m][1];
                        u32x4 w; w.x = cvt_pk_bf16(v0[0], v0[1]); w.y = cvt_pk_bf16(v0[2], v0[3]); w.z = cvt_pk_bf16(v1[0], v1[1]); w.w = cvt_pk_bf16(v1[2], v1[3]);
                        *(u32x4*)(U + ((size_t)(c0 >> 4) * 1024 + (r >> 4)) * 384 + (r & 15) * 16 + (c0 & 15)) = w; } }
            return; }
        if (pn < 16) { base = Q; ld = 2048; colt = (pn - 8) * 256; }
        else if (pn < 28) { const int t = pn - 16; base = KV + (size_t)(t >> 1) * ((size_t)M * 512); ld = 512; colt = (t & 1) * 256; }
        else {
            unsigned char* gbase = (pn < 44) ? (unsigned char*)GA : (unsigned char*)GB; const int colg = ((pn < 44) ? (pn - 28) : (pn - 44)) * 256 + wc * 32 + 8 * fq;
            const int row0 = u.pm * BM + wr * 64 + fr;
#pragma unroll
            for (int ai = 0; ai < 2; ++ai)
#pragma unroll
                for (int m = 0; m < 4; ++m) { unsigned char* rowp = gbase + (size_t)(row0 + ai * HALF + m * 16) * 4096 + colg;
#pragma unroll
                    for (int bj = 0; bj < 2; ++bj) { const f32x4 v0 = acc[ai][bj][m][0], v1 = acc[ai][bj][m][1]; unsigned q[8];
#pragma unroll
                        for (int i = 0; i < 4; ++i) { q[i] = (unsigned)fmaxf(fmaf(sigmoidf_(v0[i]), 255.f, 0.5f), 1.f); q[4 + i] = (unsigned)fmaxf(fmaf(sigmoidf_(v1[i]), 255.f, 0.5f), 1.f); }
                        u32x2 w; w.x = q[0] | (q[1] << 8) | (q[2] << 16) | (q[3] << 24); w.y = q[4] | (q[5] << 8) | (q[6] << 16) | (q[7] << 24);
                        *(u32x2*)(rowp + bj * HALF) = w; } }
            return; }
        const int row0 = u.pm * BM + wr * 64 + fr, col0 = colt + wc * 32 + 8 * fq;
#pragma unroll
        for (int ai = 0; ai < 2; ++ai)
#pragma unroll
            for (int m = 0; m < 4; ++m) { bf16_t* rowp = base + (size_t)(row0 + ai * HALF + m * 16) * ld + col0;
#pragma unroll
                for (int bj = 0; bj < 2; ++bj) { f32x4 v0 = acc[ai][bj][m][0], v1 = acc[ai][bj][m][1];
                    if (sig) {
#pragma unroll
                        for (int i = 0; i < 4; ++i) { v0[i] = sigmoidf_(v0[i]); v1[i] = sigmoidf_(v1[i]); } }
                    u32x4 w; w.x = cvt_pk_bf16(v0[0], v0[1]); w.y = cvt_pk_bf16(v0[2], v0[3]); w.z = cvt_pk_bf16(v1[0], v1[1]); w.w = cvt_pk_bf16(v1[2], v1[3]);
                    *(u32x4*)(rowp + bj * HALF) = w; } }
    }
};
struct EpiGate8 {
    static constexpr bool PERM = true, HAS_MID = false; int tmid;
    unsigned char *GA, *GB; float wscale_inv;
    __device__ __forceinline__ void mid(Acc&, const GUnit&, int, int, int, int) const {}
    __device__ __forceinline__ void operator()(const Acc& acc, const GUnit& u, int wr, int wc, int fr, int fq) const {
        unsigned char* gbase = (u.pn < 16) ? GA : GB; const int colg = (u.pn & 15) * 256 + wc * 32 + 8 * fq;
        const int row0 = u.pm * BM + wr * 64 + fr;
#pragma unroll
        for (int ai = 0; ai < 2; ++ai)
#pragma unroll
            for (int m = 0; m < 4; ++m) { unsigned char* rowp = gbase + (size_t)(row0 + ai * HALF + m * 16) * 4096 + colg;
#pragma unroll
                for (int bj = 0; bj < 2; ++bj) { const f32x4 v0 = acc[ai][bj][m][0] * wscale_inv, v1 = acc[ai][bj][m][1] * wscale_inv; unsigned q[8];
#pragma unroll
                    for (int i = 0; i < 4; ++i) { q[i] = (unsigned)fmaxf(fmaf(sigmoidf_(v0[i]), 255.f, 0.5f), 1.f); q[4 + i] = (unsigned)fmaxf(fmaf(sigmoidf_(v1[i]), 255.f, 0.5f), 1.f); }
                    u32x2 w; w.x = q[0] | (q[1] << 8) | (q[2] << 16) | (q[3] << 24); w.y = q[4] | (q[5] << 8) | (q[6] << 16) | (q[7] << 24);
                    *(u32x2*)(rowp + bj * HALF) = w; } }
    }
};
struct EpiF32Part {
    static constexpr bool PERM = false, HAS_MID = false; int tmid;
    float* dst; size_t slab_stride; int ld, ncols; int row_mul;
    __device__ __forceinline__ void mid(Acc&, const GUnit&, int, int, int, int) const {}
    __device__ __forceinline__ void operator()(const Acc& acc, const GUnit& u, int wr, int wc, int fr, int fq) const {
        float* base = dst + (size_t)u.pn * slab_stride;
        const int row0 = u.pm * row_mul + wr * 64 + fr, col0 = wc * 32 + 4 * fq;
#pragma unroll
        for (int ai = 0; ai < 2; ++ai)
#pragma unroll
            for (int m = 0; m < 4; ++m) { float* rowp = base + (size_t)(row0 + ai * HALF + m * 16) * ld + col0;
#pragma unroll
                for (int n = 0; n < 2; ++n) { if (col0 + n * 16 < ncols) *(f32x4*)(rowp + n * 16) = acc[ai][0][m][n]; } }
    }
};
struct EpiBf16Part {
    static constexpr bool PERM = false, HAS_MID = false; int tmid;
    bf16_t* dst; int ld, ncols; int row_mul;
    __device__ __forceinline__ void mid(Acc&, const GUnit&, int, int, int, int) const {}
    __device__ __forceinline__ void operator()(const Acc& acc, const GUnit& u, int wr, int wc, int fr, int fq) const {
        const int row0 = u.pm * row_mul + wr * 64 + fr, col0 = wc * 32 + 4 * fq;
#pragma unroll
        for (int ai = 0; ai < 2; ++ai)
#pragma unroll
            for (int m = 0; m < 4; ++m) { bf16_t* rowp = dst + (size_t)(row0 + ai * HALF + m * 16) * ld + col0;
#pragma unroll
                for (int n = 0; n < 2; ++n) { if (col0 + n * 16 < ncols) { const f32x4 v = acc[ai][0][m][n]; u32x2 w; w.x = cvt_pk_bf16(v[0], v[1]); w.y = cvt_pk_bf16(v[2], v[3]); *(u32x2*)(rowp + n * 16) = w; } } }
    }
};
struct EpiGlu {
    static constexpr bool PERM = true, HAS_MID = false; int tmid;
    const bf16_t* Y; const float* bias; bf16_t* O;
    __device__ __forceinline__ void mid(Acc&, const GUnit&, int, int, int, int) const {}
    __device__ __forceinline__ void operator()(const Acc& acc, const GUnit& u, int wr, int wc, int fr, int fq) const {
        const int row0 = u.pm * BM + wr * 64 + fr, col0 = u.pn * BM + wc * 32 + 8 * fq;
        f32x4 bv[2][2];
#pragma unroll
        for (int bj = 0; bj < 2; ++bj)
#pragma unroll
            for (int n = 0; n < 2; ++n) bv[bj][n] = *(const f32x4*)(bias + col0 + bj * HALF + 4 * n);
#pragma unroll
        for (int ai = 0; ai < 2; ++ai) {
            u32x4 yy[4][2];
#pragma unroll
            for (int m = 0; m < 4; ++m)
#pragma unroll
                for (int bj = 0; bj < 2; ++bj) yy[m][bj] = *(const u32x4*)(Y + (size_t)(row0 + ai * HALF + m * 16) * 2048 + col0 + bj * HALF);
#pragma unroll
            for (int m = 0; m < 4; ++m) { const size_t r = (size_t)(row0 + ai * HALF + m * 16);
#pragma unroll
                for (int bj = 0; bj < 2; ++bj) { const u32x4 yv = yy[m][bj];
                    const f32x4 v0 = acc[ai][bj][m][0] + bv[bj][0], v1 = acc[ai][bj][m][1] + bv[bj][1];
                    u32x4 w; w.x = cvt_pk_bf16(bf_lo(yv.x) * sigmoidf_(v0[0]), bf_hi(yv.x) * sigmoidf_(v0[1])); w.y = cvt_pk_bf16(bf_lo(yv.y) * sigmoidf_(v0[2]), bf_hi(yv.y) * sigmoidf_(v0[3]));
                    w.z = cvt_pk_bf16(bf_lo(yv.z) * sigmoidf_(v1[0]), bf_hi(yv.z) * sigmoidf_(v1[1])); w.w = cvt_pk_bf16(bf_lo(yv.w) * sigmoidf_(v1[2]), bf_hi(yv.w) * sigmoidf_(v1[3]));
                    *(u32x4*)(O + r * 4096 + col0 + bj * HALF) = w; } }
        }
    }
};
struct EpiMerge {
    static constexpr bool PERM = true, HAS_MID = true; int tmid;
    const unsigned char *GA, *GB; bf16_t* O;
    static __device__ __forceinline__ float ub(unsigned w, int i) { return (float)((w >> (8 * i)) & 0xffu); }
    __device__ __forceinline__ void mid(Acc& acc, const GUnit& u, int wr, int wc, int fr, int fq) const {
        int row0 = u.pm * BM + wr * 64 + fr, col0 = u.pn * BM + wc * 32 + 8 * fq;
        asm volatile("" : "+v"(row0), "+v"(col0));
        u32x2 ga[2][4][2], gb[2][4][2];
#pragma unroll
        for (int ai = 0; ai < 2; ++ai)
#pragma unroll
            for (int m = 0; m < 4; ++m) { const size_t r = (size_t)(row0 + ai * HALF + m * 16);
#pragma unroll
                for (int bj = 0; bj < 2; ++bj) { ga[ai][m][bj] = *(const u32x2*)(GA + r * 4096 + col0 + bj * HALF); gb[ai][m][bj] = *(const u32x2*)(GB + r * 4096 + col0 + bj * HALF); } }
#pragma unroll
        for (int ai = 0; ai < 2; ++ai)
#pragma unroll
            for (int m = 0; m < 4; ++m)
#pragma unroll
                for (int bj = 0; bj < 2; ++bj) { const u32x2 a = ga[ai][m][bj], b = gb[ai][m][bj]; f32x4 r0, r1;
#pragma unroll
                    for (int i = 0; i < 4; ++i) { r0[i] = ub(a.x, i) * __builtin_amdgcn_rcpf(ub(b.x, i)); r1[i] = ub(a.y, i) * __builtin_amdgcn_rcpf(ub(b.y, i)); }
                    acc[ai][bj][m][0] *= r0; acc[ai][bj][m][1] *= r1; }
        asm volatile("" ::: "memory");
    }
    __device__ __forceinline__ void operator()(const Acc& acc, const GUnit& u, int wr, int wc, int fr, int fq) const {
        const int row0 = u.pm * BM + wr * 64 + fr, col0 = u.pn * BM + wc * 32 + 8 * fq;
        u32x2 gb[2][4][2];
#pragma unroll
        for (int ai = 0; ai < 2; ++ai)
#pragma unroll
            for (int m = 0; m < 4; ++m)
#pragma unroll
                for (int bj = 0; bj < 2; ++bj) gb[ai][m][bj] = *(const u32x2*)(GB + (size_t)(row0 + ai * HALF + m * 16) * 4096 + col0 + bj * HALF);
        const float k255 = 1.0f / 255.0f;
#pragma unroll
        for (int ai = 0; ai < 2; ++ai)
#pragma unroll
            for (int m = 0; m < 4; ++m) { const size_t r = (size_t)(row0 + ai * HALF + m * 16);
#pragma unroll
                for (int bj = 0; bj < 2; ++bj) { const u32x2 b = gb[ai][m][bj];
                    const f32x4 v0 = acc[ai][bj][m][0] * k255, v1 = acc[ai][bj][m][1] * k255;
                    u32x4 w; w.x = cvt_pk_bf16(v0[0] * ub(b.x, 0), v0[1] * ub(b.x, 1)); w.y = cvt_pk_bf16(v0[2] * ub(b.x, 2), v0[3] * ub(b.x, 3));
                    w.z = cvt_pk_bf16(v1[0] * ub(b.y, 0), v1[1] * ub(b.y, 1)); w.w = cvt_pk_bf16(v1[2] * ub(b.y, 2), v1[3] * ub(b.y, 3));
                    *(u32x4*)(O + r * 4096 + col0 + bj * HALF) = w; } }
    }
};
struct EpiBf16SS {
    static constexpr bool PERM = true, HAS_MID = false; int tmid;
    bf16_t* C; float* SS;
    __device__ __forceinline__ void mid(Acc&, const GUnit&, int, int, int, int) const {}
    __device__ __forceinline__ void operator()(const Acc& acc, const GUnit& u, int wr, int wc, int fr, int fq) const {
        const int row0 = u.pm * BM + wr * 64 + fr, col0 = u.pn * BM + wc * 32 + 8 * fq;
#pragma unroll
        for (int ai = 0; ai < 2; ++ai)
#pragma unroll
            for (int m = 0; m < 4; ++m) { const int row = row0 + ai * HALF + m * 16; bf16_t* rowp = C + (size_t)row * 4096 + col0; float s = 0.f;
#pragma unroll
                for (int bj = 0; bj < 2; ++bj) { const f32x4 v0 = acc[ai][bj][m][0], v1 = acc[ai][bj][m][1];
                    s += ((v0[0] * v0[0] + v0[1] * v0[1]) + (v0[2] * v0[2] + v0[3] * v0[3])) + ((v1[0] * v1[0] + v1[1] * v1[1]) + (v1[2] * v1[2] + v1[3] * v1[3]));
                    u32x4 w; w.x = cvt_pk_bf16(v0[0], v0[1]); w.y = cvt_pk_bf16(v0[2], v0[3]); w.z = cvt_pk_bf16(v1[0], v1[1]); w.w = cvt_pk_bf16(v1[2], v1[3]);
                    *(u32x4*)(rowp + bj * HALF) = w; }
                s += __shfl_xor(s, 16); s += __shfl_xor(s, 32);
                if (fq == 0) SS[(size_t)row * 64 + u.pn * 4 + wc] = s; }
    }
};
struct EpiSwiGlu {
    static constexpr bool PERM = true, HAS_MID = false; int tmid;
    bf16_t* O;
    __device__ __forceinline__ void mid(Acc&, const GUnit&, int, int, int, int) const {}
    __device__ __forceinline__ void operator()(const Acc& acc, const GUnit& u, int wr, int wc, int fr, int fq) const {
        const int rl0 = wr * 64 + fr, col0 = u.pn * HALF + wc * 32 + 8 * fq;
        bf16_t* tile = O + ((size_t)u.pm * (DFF / 64) + (col0 >> 6)) * 16384 + (col0 & 63);
#pragma unroll
        for (int ai = 0; ai < 2; ++ai)
#pragma unroll
            for (int m = 0; m < 4; ++m) { const int rl = rl0 + ai * HALF + m * 16;
                const f32x4 g0 = acc[ai][0][m][0], g1 = acc[ai][0][m][1], u0 = acc[ai][1][m][0], u1 = acc[ai][1][m][1];
                float o[8];
#pragma unroll
                for (int i = 0; i < 4; ++i) { o[i] = g0[i] * sigmoidf_(g0[i]) * u0[i]; o[4 + i] = g1[i] * sigmoidf_(g1[i]) * u1[i]; }
                u32x4 w; w.x = cvt_pk_bf16(o[0], o[1]); w.y = cvt_pk_bf16(o[2], o[3]); w.z = cvt_pk_bf16(o[4], o[5]); w.w = cvt_pk_bf16(o[6], o[7]);
                *(u32x4*)(tile + rl * 64) = w; }
    }
};
}

#define XB_TMO      128
#define XB_XCNT(j)  (256  + 64 * (j))
#define XB_XSUB(j)  (1280 + 64 * (j))
#define XB_XGEN(j)  (2304 + 64 * (j))
#define XB_TOP      3328
#define XB_TOPGEN   3392
#define XCD_BAR_WORDS 3456
#define XB_SPIN_CAP (1u << 22)
__device__ __forceinline__ unsigned xb_ld(unsigned* p)              { return __hip_atomic_load(p, __ATOMIC_RELAXED, __HIP_MEMORY_SCOPE_AGENT); }
__device__ __forceinline__ unsigned xb_add(unsigned* p, unsigned v) { return __hip_atomic_fetch_add(p, v, __ATOMIC_RELAXED, __HIP_MEMORY_SCOPE_AGENT); }
__device__ __forceinline__ unsigned xb_xcc_id() { return (unsigned)__builtin_amdgcn_s_getreg((3 << 11) | 20) & 0xFu; }
#define XB_SPIN(cond, bar) do { unsigned _sp = 0; while (cond) { __builtin_amdgcn_s_sleep(1); \
    if ((++_sp & 255u) == 0u) { if (xb_ld(&(bar)[XB_TMO])) break; if (_sp > XB_SPIN_CAP) { atomicAdd(&(bar)[XB_TMO], 1u); break; } } } } while (0)
struct XcdBarrier { unsigned* bar; unsigned x; volatile LAS unsigned* st; };
__device__ __forceinline__ XcdBarrier xcd_barrier_post(unsigned* bar, volatile LAS unsigned* st) {
    XcdBarrier b; b.bar = bar; b.x = xb_xcc_id(); b.st = st;
    if (threadIdx.x == 0) (void)xb_add(&bar[XB_XCNT(b.x)], 1u);
    return b;
}
__device__ __forceinline__ void xcd_barrier_complete(unsigned* bar, unsigned x, unsigned& nloc, unsigned& nx) {
    const unsigned G = gridDim.x * gridDim.y * gridDim.z;
    unsigned sum, cnt, mine, sp = 0u;
    for (;;) {
        sum = 0u; cnt = 0u; mine = 0u;
#pragma unroll
        for (unsigned j = 0; j < 16; ++j) { const unsigned c = xb_ld(&bar[XB_XCNT(j)]); sum += c; cnt += (c > 0u) ? 1u : 0u; mine = (j == x) ? c : mine; }
        if (sum == G) break;
        __builtin_amdgcn_s_sleep(1);
        if ((++sp & 255u) == 0u) { if (xb_ld(&bar[XB_TMO])) break; if (sp > XB_SPIN_CAP) { atomicAdd(&bar[XB_TMO], 1u); break; } }
    }
    nloc = mine > 0u ? mine : 1u; nx = cnt > 0u ? cnt : 1u;
}
__device__ __forceinline__ void xcd_barrier(const XcdBarrier& b) {
    asm volatile("s_waitcnt vmcnt(0)" ::: "memory");
    __syncthreads();
    if (threadIdx.x == 0) {
        unsigned* bar = b.bar;
        __builtin_amdgcn_s_waitcnt(0);
        unsigned nloc = b.st[0], nx = b.st[1];
        if (nloc == 0u) { xcd_barrier_complete(bar, b.x, nloc, nx); b.st[0] = nloc; b.st[1] = nx; }
        const unsigned old = xb_add(&bar[XB_XSUB(b.x)], 1u);
        const unsigned gen = old / nloc;
        if (old + 1u == (gen + 1u) * nloc) {
            __builtin_amdgcn_fence(__ATOMIC_RELEASE, "agent");
            asm volatile("s_waitcnt vmcnt(0)" ::: "memory");
            const unsigned og = xb_add(&bar[XB_TOP], 1u);
            const unsigned tg = og / nx;
            if (og + 1u == (tg + 1u) * nx) xb_add(&bar[XB_TOPGEN], 1u);
            else XB_SPIN(xb_ld(&bar[XB_TOPGEN]) == tg, bar);
            __builtin_amdgcn_fence(__ATOMIC_ACQUIRE, "agent");
            xb_add(&bar[XB_XGEN(b.x)], 1u);
            asm volatile("s_waitcnt vmcnt(0)" ::: "memory");
        } else {
            XB_SPIN(xb_ld(&bar[XB_XGEN(b.x)]) == gen, bar);
            __builtin_amdgcn_fence(__ATOMIC_ACQUIRE, "agent");
            asm volatile("s_waitcnt vmcnt(0)" ::: "memory");
        }
    }
    __syncthreads();
}

struct Frame {
    LAS unsigned char* lds;
    int tid, lane, wave, vcu, G;
    const float* const* in;
    unsigned char* ws; float* out;
};
enum { I_X = 0, I_NMIXPRE, I_WIN, I_ARE, I_AIM, I_LOGDT, I_BRE, I_BIM, I_CRE, I_CIM, I_SSMD, I_WGLU, I_BGLU, I_PEK, I_W1K, I_W2K, I_PEV, I_W1V, I_W2V,
       I_WPA, I_WPB, I_WOUT, I_NMIXPOST, I_NFFNPRE, I_WGATE, I_WUP, I_WDOWN, I_NFFNPOST, N_IN };

__device__ __forceinline__ void p0_tr_item(const float* W, int N, int k0, int n_src0, bf16_t* WT, size_t ldt, int drow0, int dcol0, LAS float* scr, int lane) {
#pragma unroll 8
    for (int i = 0; i < 32; ++i) { const int kk = 2 * i + (lane >> 5); scr[kk * 33 + (lane & 31)] = W[(size_t)(k0 + kk) * N + n_src0 + (lane & 31)]; }
    LDS_WAIT(); asm volatile("" ::: "memory");
    const int c = lane & 7;
#pragma unroll
    for (int j = 0; j < 4; ++j) { const int n = (lane >> 3) + 8 * j; const LAS float* s = scr + (8 * c) * 33 + n;
        u32x4 o; o.x = pk2(s[0 * 33], s[1 * 33]); o.y = pk2(s[2 * 33], s[3 * 33]); o.z = pk2(s[4 * 33], s[5 * 33]); o.w = pk2(s[6 * 33], s[7 * 33]);
        *(GAS u32x4*)(WT + (size_t)(drow0 + n) * ldt + dcol0 + 8 * c) = o; }
    LDS_WAIT(); asm volatile("" ::: "memory");
}
__device__ __forceinline__ void p0_tr_item_fp8(const float* W, int N, int k0, int n_src0, unsigned char* WT, size_t ldt, int drow0, int dcol0, float scale, LAS float* scr, int lane) {
#pragma unroll 8
    for (int i = 0; i < 32; ++i) { const int kk = 2 * i + (lane >> 5); scr[kk * 33 + (lane & 31)] = W[(size_t)(k0 + kk) * N + n_src0 + (lane & 31)]; }
    LDS_WAIT(); asm volatile("" ::: "memory");
    const int c = lane & 7;
#pragma unroll
    for (int j = 0; j < 4; ++j) { const int n = (lane >> 3) + 8 * j; const LAS float* s = scr + (8 * c) * 33 + n;
        int w0 = __builtin_amdgcn_cvt_pk_fp8_f32(s[0 * 33] * scale, s[1 * 33] * scale, 0, false); w0 = __builtin_amdgcn_cvt_pk_fp8_f32(s[2 * 33] * scale, s[3 * 33] * scale, w0, true);
        int w1 = __builtin_amdgcn_cvt_pk_fp8_f32(s[4 * 33] * scale, s[5 * 33] * scale, 0, false); w1 = __builtin_amdgcn_cvt_pk_fp8_f32(s[6 * 33] * scale, s[7 * 33] * scale, w1, true);
        *(GAS u32x2*)(WT + (size_t)(drow0 + n) * ldt + dcol0 + 8 * c) = (u32x2){(unsigned)w0, (unsigned)w1}; }
    LDS_WAIT(); asm volatile("" ::: "memory");
}
__device__ __forceinline__ void s5_precompute_item(Frame& F, int g, int tau);
__device__ __forceinline__ void p0_side(Frame& F, int sw, int nsw) {
    for (int it = sw; it < NGRP * 17; it += nsw) s5_precompute_item(F, it / 17, it % 17);
    for (int o = sw; o < 256; o += nsw) {
        const int kv = o >> 7, n = o & 127; const float* pe = F.in[kv ? I_PEV : I_PEK]; const float* w1 = F.in[kv ? I_W1V : I_W1K];
        float s = 0.f;
        for (int k = F.lane; k < 4096; k += 64) s += pe[k] * w1[(size_t)k * 128 + n];
        s = wave_sum(s);
        if (F.lane == 0) ((float*)(F.ws + WS_CB1))[o] = s;
    }
}
__device__ __forceinline__ void p0_prologue(Frame& F) {
    LAS float* scr = (LAS float*)(F.lds + F.wave * 16384);
    const int gw = F.vcu * NWAVES + F.wave, NGW = F.G * NWAVES;
    unsigned char* ws = F.ws;
    constexpr int KB = DM / 64;
    constexpr int I_IN = KB * (7168 / 32), I_G8 = KB * (8192 / 32), I_GN = KB * (256 / 32), I_GLU = (2048 / 64) * (2048 / 32), I_PA = (2048 / 64) * (4096 / 32), I_PB = I_PA, I_OUT = KB * (4096 / 32);
    constexpr int I_G = KB * (DFF / 32), I_U = I_G, I_D = (DFF / 64) * (4096 / 32), I_W1 = 2 * KB * (128 / 32), I_W2 = 2 * 2 * 4;
    constexpr int NITEMS = I_IN + I_G8 + I_GN + I_G + I_U + I_W1 + I_W2; (void)I_D; (void)I_GLU; (void)I_PA; (void)I_PB; (void)I_OUT;
    const bool split = (NGW == 2048);
    if (split && F.wave >= 6) p0_side(F, F.vcu * 2 + (F.wave - 6), F.G * 2);
    const int tw = split ? F.vcu * 6 + F.wave : gw, TNGW = split ? F.G * 6 : NGW;
    for (int it = (split && F.wave >= 6) ? NITEMS : tw; it < NITEMS; it += TNGW) {
        int r = it;
        if (r < I_IN) { const int nb = r % 224, kb = r / 224, d0 = nb * 32; p0_tr_item(F.in[I_WIN], INW, kb * 64, d0, (bf16_t*)(ws + WS_WIN), 4096, d0, kb * 64, scr, F.lane); continue; } r -= I_IN;
        if (r < I_G8) { const int nb = r % 256, kb = r / 256, d0 = nb * 32; p0_tr_item_fp8(F.in[I_WIN], INW, kb * 64, 7216 + d0, ws + WS_WG8, 4096, d0, kb * 64, GATE_WSCALE, scr, F.lane); continue; } r -= I_G8;
        if (r < I_GN) { const int nb = r % 8, kb = r / 8; p0_tr_item(F.in[I_WIN], INW, kb * 64, 7168 + nb * 32, (bf16_t*)(ws + WS_WGN), 4096, nb * 32, kb * 64, scr, F.lane); continue; } r -= I_GN;
        if (r < I_G) { const int nb = r % 344, kb = r / 344, j = nb * 32; p0_tr_item(F.in[I_WGATE], DFF, kb * 64, j, (bf16_t*)(ws + WS_WGU), 4096, (j >> 7) * 256 + (j & 127), kb * 64, scr, F.lane); continue; } r -= I_G;
        if (r < I_U) { const int nb = r % 344, kb = r / 344, j = nb * 32; p0_tr_item(F.in[I_WUP], DFF, kb * 64, j, (bf16_t*)(ws + WS_WGU), 4096, (j >> 7) * 256 + 128 + (j & 127), kb * 64, scr, F.lane); continue; } r -= I_U;
        if (r < I_W1) { const int kv = r / (KB * 4), q = r % (KB * 4), nb = q % 4, kb = q / 4;
            const int l = kb >> 1, h = kb & 1; p0_tr_item(F.in[kv ? I_W1V : I_W1K], 128, kb * 64, nb * 32, (bf16_t*)(ws + WS_W1T) + (size_t)kv * 128 * 4096, 4096, nb * 32, h * 2048 + l * 64, scr, F.lane); continue; } r -= I_W1;
        { const int kv = r / 8, q = r % 8, nb = q % 4, kb = q / 4; p0_tr_item(F.in[kv ? I_W2V : I_W2K], 128, kb * 64, nb * 32, (bf16_t*)(ws + WS_W2T) + (size_t)kv * 128 * 128, 128, nb * 32, kb * 64, scr, F.lane); }
    }
    {
        const GAS f32x4* gn = (const GAS f32x4*)F.in[I_NMIXPRE] + F.lane;
        f32x4 va[16], vb[16];
#define HN_LOAD(V, m) do { const GAS f32x4* xr = (const GAS f32x4*)(F.in[I_X] + (size_t)(m) * DM) + F.lane; _Pragma("unroll") for (int j = 0; j < 16; ++j) V[j] = __builtin_nontemporal_load((const f32x4*)&xr[64 * j]); } while (0)
#define HN_PROC(V, m) do { float s_ = 0.f; _Pragma("unroll") for (int j = 0; j < 16; ++j) s_ += (V[j].x * V[j].x + V[j].y * V[j].y) + (V[j].z * V[j].z + V[j].w * V[j].w); \
        const float rs = 1.0f / sqrtf(wave_sum(s_) * (1.f / DM) + RMS_EPS); GAS u32x2* o8 = (GAS u32x2*)((bf16_t*)(ws + WS_HN) + (size_t)(m) * DM) + F.lane; \
        GAS unsigned* o4 = (GAS unsigned*)(ws + WS_HN8 + (size_t)(m) * DM) + F.lane; \
        _Pragma("unroll") for (int j = 0; j < 16; ++j) { const f32x4 g = gn[64 * j]; const float h0 = V[j].x * rs * g.x, h1 = V[j].y * rs * g.y, h2 = V[j].z * rs * g.z, h3 = V[j].w * rs * g.w; \
            u32x2 w; w.x = cvt_pk_bf16(h0, h1); w.y = cvt_pk_bf16(h2, h3); o8[64 * j] = w; \
            int q = __builtin_amdgcn_cvt_pk_fp8_f32(h0, h1, 0, false); q = __builtin_amdgcn_cvt_pk_fp8_f32(h2, h3, q, true); o4[64 * j] = (unsigned)q; } } while (0)
        int m = gw;
        if (m < M) HN_LOAD(va, m);
        for (; m < M; m += 2 * NGW) {
            const int m1 = m + NGW, m2 = m + 2 * NGW;
            if (m1 < M) HN_LOAD(vb, m1);
            HN_PROC(va, m);
            if (m1 < M) { if (m2 < M) HN_LOAD(va, m2); HN_PROC(vb, m1); }
        }
#undef HN_LOAD
#undef HN_PROC
    }
    if (!split) p0_side(F, gw, NGW);
}

__device__ __forceinline__ void s5_precompute_item(Frame& F, int g, int tau) {
    const int p = F.lane, gp = g * 64 + p;
    const float dt = expf(F.in[I_LOGDT][g]); const float ar = F.in[I_ARE][gp], ai = F.in[I_AIM][gp];
    const float decay = expf(dt * ar); float sn, cs; sincosf(dt * ai, &sn, &cs);
    const float abr = decay * cs, abi = decay * sn;
    const float den = ar * ar + ai * ai;
    const float zr = ((abr - 1.0f) * ar + abi * ai) / den, zi = (abi * ar - (abr - 1.0f) * ai) / den;
    float pwr = 1.f, pwi = 0.f;
    for (int k = 0; k < tau; ++k) { const float nr = pwr * abr - pwi * abi, ni = pwr * abi + pwi * abr; pwr = nr; pwi = ni; }
    bf16_t* STT = (bf16_t*)(F.ws + WS_STT) + (size_t)g * 128 * 256; bf16_t* TGT = (bf16_t*)(F.ws + WS_TGT) + (size_t)g * 256 * 384;
    if (tau == 16) { float* A16 = (float*)(F.ws + WS_SSMP); A16[gp * 2] = pwr; A16[gp * 2 + 1] = pwi; }
    float bbr[16], bbi[16];
    if (tau <= 15) {
        const float* br = F.in[I_BRE] + (size_t)gp * 16; const float* bi = F.in[I_BIM] + (size_t)gp * 16;
#pragma unroll
        for (int c = 0; c < 16; ++c) { bbr[c] = zr * br[c] - zi * bi[c]; bbi[c] = zr * bi[c] + zi * br[c]; }
        unsigned wr_[8], wi_[8];
#pragma unroll
        for (int c = 0; c < 8; ++c) { wr_[c] = pk2(pwr * bbr[2 * c] - pwi * bbi[2 * c], pwr * bbr[2 * c + 1] - pwi * bbi[2 * c + 1]); wi_[c] = pk2(pwr * bbi[2 * c] + pwi * bbr[2 * c], pwr * bbi[2 * c + 1] + pwi * bbr[2 * c + 1]); }
        const int s_ = 15 - tau;
        *(u32x4*)(STT + (size_t)p * 256 + s_ * 16) = (u32x4){wr_[0], wr_[1], wr_[2], wr_[3]}; *(u32x4*)(STT + (size_t)p * 256 + s_ * 16 + 8) = (u32x4){wr_[4], wr_[5], wr_[6], wr_[7]};
        *(u32x4*)(STT + (size_t)(64 + p) * 256 + s_ * 16) = (u32x4){wi_[0], wi_[1], wi_[2], wi_[3]}; *(u32x4*)(STT + (size_t)(64 + p) * 256 + s_ * 16 + 8) = (u32x4){wi_[4], wi_[5], wi_[6], wi_[7]};
    }
    const float* CR = F.in[I_CRE] + (size_t)g * 16 * 64 + p; const float* CI = F.in[I_CIM] + (size_t)g * 16 * 64 + p;
    float kv[16];
    const bool b5 = (p & 32) != 0, b4 = (p & 16) != 0, b3 = (p & 8) != 0, b2 = (p & 4) != 0;
#pragma unroll
    for (int c = 0; c < 16; ++c) {
        const float cr = CR[c * 64], ci = CI[c * 64];
        const float cpr = cr * pwr - ci * pwi, cpi = cr * pwi + ci * pwr;
        if (tau >= 1) { const int n = (tau - 1) * 16 + c; TGT[(size_t)n * 384 + 256 + p] = (bf16_t)f2bf(cpr); TGT[(size_t)n * 384 + 320 + p] = (bf16_t)f2bf(-cpi); }
        if (tau <= 15) {
            float v[16];
#pragma unroll
            for (int q = 0; q < 16; ++q) v[q] = cpr * bbr[q] - cpi * bbi[q];
            float w8[8], w4[4], w2[2];
#pragma unroll
            for (int j = 0; j < 8; ++j) { const float give = b5 ? v[j] : v[j + 8], keep = b5 ? v[j + 8] : v[j]; w8[j] = keep + __shfl_xor(give, 32); }
#pragma unroll
            for (int j = 0; j < 4; ++j) { const float give = b4 ? w8[j] : w8[j + 4], keep = b4 ? w8[j + 4] : w8[j]; w4[j] = keep + __shfl_xor(give, 16); }
#pragma unroll
            for (int j = 0; j < 2; ++j) { const float give = b3 ? w4[j] : w4[j + 2], keep = b3 ? w4[j + 2] : w4[j]; w2[j] = keep + __shfl_xor(give, 8); }
            float y; { const float give = b2 ? w2[0] : w2[1], keep = b2 ? w2[1] : w2[0]; y = keep + __shfl_xor(give, 4); }
            y += __shfl_xor(y, 2); y += __shfl_xor(y, 1);
            if (tau == 0 && (p >> 2) == c) y += F.in[I_SSMD][g * 16 + c];
            kv[c] = y;
        }
    }
    if (tau <= 15) {
        const int cq = p >> 2;
        for (int s_ = 0; s_ + tau < 16; ++s_) { const int t_ = s_ + tau;
            if ((p & 3) == 0) {
#pragma unroll
                for (int c = 0; c < 16; ++c) TGT[(size_t)(t_ * 16 + c) * 384 + s_ * 16 + cq] = (bf16_t)f2bf(kv[c]); }
            if (tau >= 1) {
#pragma unroll
                for (int i = 0; i < 4; ++i) { const int q = p + 64 * i; TGT[(size_t)(s_ * 16 + (q >> 4)) * 384 + t_ * 16 + (q & 15)] = (bf16_t)0; } }
        }
    }
}
__device__ __forceinline__ void s5_scan(Frame& F) {
    const int gw = F.vcu * NWAVES + F.wave, NGW = F.G * NWAVES;
    const bf16_t* HC = (const bf16_t*)(F.ws + WS_HC); const float* A16 = (const float*)(F.ws + WS_SSMP); bf16_t* UH = (bf16_t*)(F.ws + WS_UH);
    for (int task = gw; task < 512; task += NGW) {
        const int g = task >> 2, b = task & 3, p = F.lane;
        const float a_r = A16[(g * 64 + p) * 2], a_i = A16[(g * 64 + p) * 2 + 1];
        const size_t row0 = (size_t)g * 1024 + b * 256;
        float hr = 0.f, hi = 0.f;
        float era[32], eia[32], erb[32], eib[32];
#define SC_LOAD(ER, EI, k0) do { _Pragma("unroll") for (int k = 0; k < 32; ++k) { ER[k] = __builtin_bit_cast(float, (unsigned)HC[(row0 + (k0) + k) * 128 + p] << 16); EI[k] = __builtin_bit_cast(float, (unsigned)HC[(row0 + (k0) + k) * 128 + 64 + p] << 16); } } while (0)
#define SC_STEP(ER, EI, k0) do { _Pragma("unroll") for (int k = 0; k < 32; ++k) { bf16_t* up = UH + (row0 + (k0) + k) * 384 + 256 + p; up[0] = (bf16_t)f2bf(hr); up[64] = (bf16_t)f2bf(hi); \
            const float nr = a_r * hr - a_i * hi + ER[k], ni = a_r * hi + a_i * hr + EI[k]; hr = nr; hi = ni; } } while (0)
        SC_LOAD(era, eia, 0);
        for (int k0 = 0; k0 < 256; k0 += 64) {
            SC_LOAD(erb, eib, k0 + 32);
            SC_STEP(era, eia, k0);
            if (k0 + 64 < 256) SC_LOAD(era, eia, k0 + 64);
            SC_STEP(erb, eib, k0 + 32);
        }
#undef SC_LOAD
#undef SC_STEP
    }
}
struct OrdS5 {
    const char* UHb; const char* Bm; size_t bstride; int G, c;
    __device__ __forceinline__ bool next(int i, pg8::GUnit& u) const {
        const int L = i * G + c; if (L >= 512) return false;
        const int g = L >> 2;
        u.a = UHb + (size_t)L * 256 * 768; u.b = Bm + (size_t)g * bstride; u.pm = L; u.pn = 0; return true;
    }
};
namespace pg8 {
struct EpiS5Y {
    static constexpr bool PERM = true, HAS_MID = false; int tmid;
    bf16_t* Y;
    __device__ __forceinline__ void mid(Acc&, const GUnit&, int, int, int, int) const {}
    __device__ __forceinline__ void operator()(const Acc& acc, const GUnit& u, int wr, int wc, int fr, int fq) const {
        const int g = u.pm >> 2, ck0 = (u.pm & 3) * 256 + wr * 64 + fr;
#pragma unroll
        for (int ai = 0; ai < 2; ++ai)
#pragma unroll
            for (int m = 0; m < 4; ++m) { const int ck = ck0 + ai * HALF + m * 16;
#pragma unroll
                for (int bj = 0; bj < 2; ++bj) { const int n0 = bj * HALF + wc * 32 + 8 * fq; const f32x4 v0 = acc[ai][bj][m][0], v1 = acc[ai][bj][m][1];
                    u32x4 w; w.x = cvt_pk_bf16(gelu_tanh(v0[0]), gelu_tanh(v0[1])); w.y = cvt_pk_bf16(gelu_tanh(v0[2]), gelu_tanh(v0[3]));
                    w.z = cvt_pk_bf16(gelu_tanh(v1[0]), gelu_tanh(v1[1])); w.w = cvt_pk_bf16(gelu_tanh(v1[2]), gelu_tanh(v1[3]));
                    *(u32x4*)(Y + ((size_t)ck * 16 + (n0 >> 4)) * 2048 + g * 16 + (n0 & 15)) = w; } }
    }
};
}

__device__ __forceinline__ int crow(int r, int hi) { return (r & 3) + 8 * (r >> 2) + 4 * hi; }
__device__ __forceinline__ void compress2(Frame& F) {
    const float* CP = (const float*)(F.ws + WS_CP); const float* cb1 = (const float*)(F.ws + WS_CB1);
    const bf16_t* W2T = (const bf16_t*)(F.ws + WS_W2T); bf16_t* KC = (bf16_t*)(F.ws + WS_KC);
    LAS unsigned char* H = F.lds;
    const int c2off = (F.G >= 192) ? 64 : 0;
    for (int unit = F.vcu - c2off; unit >= 0 && unit < 128; unit += F.G) {
        const int R0 = unit * 64, kv = R0 >> 12;
        { const int row = F.tid >> 3, cs = (F.tid & 7) * 16;
          f32x4 a[4];
#pragma unroll
          for (int q = 0; q < 4; ++q) a[q] = *(const f32x4*)(cb1 + kv * 128 + cs + 4 * q);
#pragma unroll
          for (int s = 0; s < 8; ++s)
#pragma unroll
              for (int q = 0; q < 4; ++q) a[q] += *(const f32x4*)(CP + ((size_t)s * 8192 + R0 + row) * 128 + cs + 4 * q);
          u32x4 w0, w1;
          w0.x = pk2(gelu_tanh(a[0].x), gelu_tanh(a[0].y)); w0.y = pk2(gelu_tanh(a[0].z), gelu_tanh(a[0].w)); w0.z = pk2(gelu_tanh(a[1].x), gelu_tanh(a[1].y)); w0.w = pk2(gelu_tanh(a[1].z), gelu_tanh(a[1].w));
          w1.x = pk2(gelu_tanh(a[2].x), gelu_tanh(a[2].y)); w1.y = pk2(gelu_tanh(a[2].z), gelu_tanh(a[2].w)); w1.z = pk2(gelu_tanh(a[3].x), gelu_tanh(a[3].y)); w1.w = pk2(gelu_tanh(a[3].z), gelu_tanh(a[3].w));
          *(LAS u32x4*)(H + row * 272 + cs * 2) = w0; *(LAS u32x4*)(H + row * 272 + cs * 2 + 16) = w1; }
        __syncthreads();
        { const int rb = F.wave >> 2, cb = F.wave & 3, r32 = F.lane & 31, hi = F.lane >> 5;
          f32x16 acc = {};
#pragma unroll
          for (int k0 = 0; k0 < 8; ++k0) {
              const bf16x8 a = *(const LAS bf16x8*)(H + (rb * 32 + r32) * 272 + (k0 * 16 + hi * 8) * 2);
              const bf16x8 bq = *(const bf16x8*)(W2T + ((size_t)kv * 128 + cb * 32 + r32) * 128 + k0 * 16 + hi * 8);
              acc = __builtin_amdgcn_mfma_f32_32x32x16_bf16(a, bq, acc, 0, 0, 0); }
#pragma unroll
          for (int r = 0; r < 16; ++r) { const int R = R0 + rb * 32 + crow(r, hi); const float v = ((R & 255) == 255) ? 0.f : acc[r];
              KC[(size_t)R * 128 + cb * 32 + r32] = (bf16_t)f2bf(v); } }
        __syncthreads();
    }
}

namespace att {
constexpr float SCALE = 0.08838834764831845f, CL2 = SCALE * 1.4426950408889634f, THR = 8.f;
constexpr int KVT = 16384;
constexpr int L_K = 0, L_V = 32768, L_WS = 65536, WSB = 8192;
#define KSWZ(row, colB) ((row) * 256 + ((colB) ^ (((row) & 7) << 4)))
#define SBAR() __builtin_amdgcn_sched_barrier(0)
__device__ __forceinline__ int v_st(int k, int c) { const int kk = (k & ~0xC) | ((k & 4) << 1) | ((k & 8) >> 1); return ((kk >> 3) * 4 + (c >> 5)) * 512 + ((kk & 7) * 32 + (c & 31)) * 2; }
__device__ __forceinline__ int v_rd_base(int lane) { return ((lane & 3) << 3) | (((lane >> 2) & 3) << 6) | (((lane >> 4) & 1) << 5) | (((lane >> 5) & 1) << 8); }
constexpr int v_rd_off(int d0, int ks, int half) { return d0 * 512 + ks * 4096 + half * 2048; }
template <int OFF> __device__ __forceinline__ s16x4 tr_read(int vb) { s16x4 r; asm volatile("ds_read_b64_tr_b16 %0, %1 offset:%2" : "=&v"(r) : "v"(vb), "i"(OFF) : "memory"); return r; }
template <int D0> __device__ __forceinline__ void pv_one(f32x16& od, int vb, bf16x8 pa0, bf16x8 pa1, bf16x8 pa2, bf16x8 pa3) {
    const s16x4 l0 = tr_read<v_rd_off(D0, 0, 0)>(vb), h0 = tr_read<v_rd_off(D0, 0, 1)>(vb), l1 = tr_read<v_rd_off(D0, 1, 0)>(vb), h1 = tr_read<v_rd_off(D0, 1, 1)>(vb);
    const s16x4 l2 = tr_read<v_rd_off(D0, 2, 0)>(vb), h2 = tr_read<v_rd_off(D0, 2, 1)>(vb), l3 = tr_read<v_rd_off(D0, 3, 0)>(vb), h3 = tr_read<v_rd_off(D0, 3, 1)>(vb);
    asm volatile("s_waitcnt lgkmcnt(0)" ::: "memory"); SBAR();
#define PK(L, H) (bf16x8){L[0], L[1], L[2], L[3], H[0], H[1], H[2], H[3]}
    od = __builtin_amdgcn_mfma_f32_32x32x16_bf16(pa0, PK(l0, h0), od, 0, 0, 0);
    od = __builtin_amdgcn_mfma_f32_32x32x16_bf16(pa1, PK(l1, h1), od, 0, 0, 0);
    od = __builtin_amdgcn_mfma_f32_32x32x16_bf16(pa2, PK(l2, h2), od, 0, 0, 0);
    od = __builtin_amdgcn_mfma_f32_32x32x16_bf16(pa3, PK(l3, h3), od, 0, 0, 0);
#undef PK
}
__device__ __forceinline__ void pv_d0(f32x16* o, int vb, bf16x8 pa0, bf16x8 pa1, bf16x8 pa2, bf16x8 pa3) {
    pv_one<0>(o[0], vb, pa0, pa1, pa2, pa3); pv_one<1>(o[1], vb, pa0, pa1, pa2, pa3); pv_one<2>(o[2], vb, pa0, pa1, pa2, pa3); pv_one<3>(o[3], vb, pa0, pa1, pa2, pa3);
}
struct VFrag { s16x4 l0, h0, l1, h1, l2, h2, l3, h3; };
template <int D0> __device__ __forceinline__ void pv_rd(VFrag& f, int vb) {
    f.l0 = tr_read<v_rd_off(D0, 0, 0)>(vb); f.h0 = tr_read<v_rd_off(D0, 0, 1)>(vb); f.l1 = tr_read<v_rd_off(D0, 1, 0)>(vb); f.h1 = tr_read<v_rd_off(D0, 1, 1)>(vb);
    f.l2 = tr_read<v_rd_off(D0, 2, 0)>(vb); f.h2 = tr_read<v_rd_off(D0, 2, 1)>(vb); f.l3 = tr_read<v_rd_off(D0, 3, 0)>(vb); f.h3 = tr_read<v_rd_off(D0, 3, 1)>(vb);
}
__device__ __forceinline__ void pv_mm(f32x16& od, const VFrag& f, bf16x8 pa0, bf16x8 pa1, bf16x8 pa2, bf16x8 pa3) {
#define PK(L, H) (bf16x8){L[0], L[1], L[2], L[3], H[0], H[1], H[2], H[3]}
    od = __builtin_amdgcn_mfma_f32_32x32x16_bf16(pa0, PK(f.l0, f.h0), od, 0, 0, 0);
    od = __builtin_amdgcn_mfma_f32_32x32x16_bf16(pa1, PK(f.l1, f.h1), od, 0, 0, 0);
    od = __builtin_amdgcn_mfma_f32_32x32x16_bf16(pa2, PK(f.l2, f.h2), od, 0, 0, 0);
    od = __builtin_amdgcn_mfma_f32_32x32x16_bf16(pa3, PK(f.l3, f.h3), od, 0, 0, 0);
#undef PK
}
__device__ __forceinline__ void pv_pipe(f32x16* o, int vb, bf16x8 pa0, bf16x8 pa1, bf16x8 pa2, bf16x8 pa3) {
    VFrag fa, fb;
    asm volatile("s_waitcnt lgkmcnt(0)" ::: "memory");
    pv_rd<0>(fa, vb); pv_rd<1>(fb, vb);
    asm volatile("s_waitcnt lgkmcnt(8)" ::: "memory"); SBAR(); pv_mm(o[0], fa, pa0, pa1, pa2, pa3); SBAR();
    pv_rd<2>(fa, vb);
    asm volatile("s_waitcnt lgkmcnt(8)" ::: "memory"); SBAR(); pv_mm(o[1], fb, pa0, pa1, pa2, pa3); SBAR();
    pv_rd<3>(fb, vb);
    asm volatile("s_waitcnt lgkmcnt(8)" ::: "memory"); SBAR(); pv_mm(o[2], fa, pa0, pa1, pa2, pa3); SBAR();
    asm volatile("s_waitcnt lgkmcnt(0)" ::: "memory"); SBAR(); pv_mm(o[3], fb, pa0, pa1, pa2, pa3); SBAR();
}
__device__ __forceinline__ void qkt_pipe(f32x16& p0, f32x16& p1, LAS unsigned char* Ks, const bf16x8* qr, int r32, int hi) {
#define LDK(d0, half) (*(const LAS bf16x8*)(Ks + KSWZ((half) * 32 + r32, ((d0) * 16 + hi * 8) * 2)))
    bf16x8 f0 = LDK(0, 0), f1 = LDK(0, 1), f2 = LDK(1, 0), f3 = LDK(1, 1), f4 = LDK(2, 0), f5 = LDK(2, 1);
    SBAR();
    p0 = __builtin_amdgcn_mfma_f32_32x32x16_bf16(f0, qr[0], f32x16{}, 0, 0, 0); p1 = __builtin_amdgcn_mfma_f32_32x32x16_bf16(f1, qr[0], f32x16{}, 0, 0, 0); SBAR();
    f0 = LDK(3, 0); f1 = LDK(3, 1); SBAR();
    p0 = __builtin_amdgcn_mfma_f32_32x32x16_bf16(f2, qr[1], p0, 0, 0, 0); p1 = __builtin_amdgcn_mfma_f32_32x32x16_bf16(f3, qr[1], p1, 0, 0, 0); SBAR();
    f2 = LDK(4, 0); f3 = LDK(4, 1); SBAR();
    p0 = __builtin_amdgcn_mfma_f32_32x32x16_bf16(f4, qr[2], p0, 0, 0, 0); p1 = __builtin_amdgcn_mfma_f32_32x32x16_bf16(f5, qr[2], p1, 0, 0, 0); SBAR();
    f4 = LDK(5, 0); f5 = LDK(5, 1); SBAR();
    p0 = __builtin_amdgcn_mfma_f32_32x32x16_bf16(f0, qr[3], p0, 0, 0, 0); p1 = __builtin_amdgcn_mfma_f32_32x32x16_bf16(f1, qr[3], p1, 0, 0, 0); SBAR();
    f0 = LDK(6, 0); f1 = LDK(6, 1); SBAR();
    p0 = __builtin_amdgcn_mfma_f32_32x32x16_bf16(f2, qr[4], p0, 0, 0, 0); p1 = __builtin_amdgcn_mfma_f32_32x32x16_bf16(f3, qr[4], p1, 0, 0, 0); SBAR();
    f2 = LDK(7, 0); f3 = LDK(7, 1); SBAR();
    p0 = __builtin_amdgcn_mfma_f32_32x32x16_bf16(f4, qr[5], p0, 0, 0, 0); p1 = __builtin_amdgcn_mfma_f32_32x32x16_bf16(f5, qr[5], p1, 0, 0, 0); SBAR();
    p0 = __builtin_amdgcn_mfma_f32_32x32x16_bf16(f0, qr[6], p0, 0, 0, 0); p1 = __builtin_amdgcn_mfma_f32_32x32x16_bf16(f1, qr[6], p1, 0, 0, 0); SBAR();
    p0 = __builtin_amdgcn_mfma_f32_32x32x16_bf16(f2, qr[7], p0, 0, 0, 0); p1 = __builtin_amdgcn_mfma_f32_32x32x16_bf16(f3, qr[7], p1, 0, 0, 0); SBAR();
#undef LDK
}
__device__ __forceinline__ void qkt(f32x16& p0, f32x16& p1, LAS unsigned char* Ks, const bf16x8* qr, int r32, int hi) {
    p0 = f32x16{}; p1 = f32x16{};
#pragma unroll
    for (int d0 = 0; d0 < 8; ++d0) { const int cb = (d0 * 16 + hi * 8) * 2;
        const bf16x8 b0 = *(const LAS bf16x8*)(Ks + KSWZ(r32, cb));
        const bf16x8 b1 = *(const LAS bf16x8*)(Ks + KSWZ(32 + r32, cb));
        p0 = __builtin_amdgcn_mfma_f32_32x32x16_bf16(b0, qr[d0], p0, 0, 0, 0);
        p1 = __builtin_amdgcn_mfma_f32_32x32x16_bf16(b1, qr[d0], p1, 0, 0, 0); }
}
__device__ __forceinline__ float swap_max(float v) { auto rr = __builtin_amdgcn_permlane32_swap(__float_as_uint(v), __float_as_uint(v), false, false); return fmaxf(__uint_as_float(rr[0]), __uint_as_float(rr[1])); }
__device__ __forceinline__ float swap_sum(float v) { auto rr = __builtin_amdgcn_permlane32_swap(__float_as_uint(v), __float_as_uint(v), false, false); return __uint_as_float(rr[0]) + __uint_as_float(rr[1]); }
__device__ __forceinline__ void pack_p(const f32x16& p0, const f32x16& p1, bf16x8& pa0, bf16x8& pa1, bf16x8& pa2, bf16x8& pa3) {
#define PK4(P, BASE, OUT) do { unsigned a0 = cvt_pk_bf16(P[BASE + 0], P[BASE + 1]), a1 = cvt_pk_bf16(P[BASE + 2], P[BASE + 3]);   \
    unsigned b0 = cvt_pk_bf16(P[BASE + 4], P[BASE + 5]), b1 = cvt_pk_bf16(P[BASE + 6], P[BASE + 7]);                              \
    auto r0 = __builtin_amdgcn_permlane32_swap(a0, b0, false, false); auto r1 = __builtin_amdgcn_permlane32_swap(a1, b1, false, false); \
    u32x4 w = {r0[0], r1[0], r0[1], r1[1]}; OUT = __builtin_bit_cast(bf16x8, w); } while (0)
    PK4(p0, 0, pa0); PK4(p0, 8, pa1); PK4(p1, 0, pa2); PK4(p1, 8, pa3);
#undef PK4
}
struct Stg { bf16x8 k0, k1, v0, v1; };
template <bool WITHV> __device__ __forceinline__ void gload(Stg& s, const bf16_t* Kp, const bf16_t* Vp, size_t ld, int sr, int sc) {
    s.k0 = *(const bf16x8*)(Kp + (size_t)sr * ld + sc); s.k1 = *(const bf16x8*)(Kp + (size_t)(32 + sr) * ld + sc);
    if (WITHV) { s.v0 = *(const bf16x8*)(Vp + (size_t)sr * ld + sc); s.v1 = *(const bf16x8*)(Vp + (size_t)(32 + sr) * ld + sc); }
}
template <bool WITHV> __device__ __forceinline__ void lwrite(LAS unsigned char* lds, int buf, const Stg& s, int sr, int sc) {
    *(LAS bf16x8*)(lds + L_K + buf * KVT + KSWZ(sr, sc * 2)) = s.k0; *(LAS bf16x8*)(lds + L_K + buf * KVT + KSWZ(32 + sr, sc * 2)) = s.k1;
    if (WITHV) { *(LAS bf16x8*)(lds + L_V + buf * KVT + v_st(sr, sc)) = s.v0; *(LAS bf16x8*)(lds + L_V + buf * KVT + v_st(32 + sr, sc)) = s.v1; }
}
__device__ __forceinline__ void flash_step(f32x16& p0, f32x16& p1, float& m_reg, float& l_reg, f32x16* o, int vb, LAS float* al_l, int r32, int hi) {
    float pmax = p0[0];
#pragma unroll
    for (int r = 1; r < 16; ++r) pmax = fmaxf(pmax, p0[r]);
#pragma unroll
    for (int r = 0; r < 16; ++r) pmax = fmaxf(pmax, p1[r]);
    pmax = swap_max(pmax);
    float mn, alpha;
    if (__all(pmax - m_reg <= THR / SCALE)) { mn = m_reg; alpha = 1.f; }
    else { mn = fmaxf(m_reg, pmax); alpha = __builtin_amdgcn_exp2f((m_reg - mn) * CL2); m_reg = mn; }
    const float mnC = -mn * CL2;
    float ps = 0.f;
#pragma unroll
    for (int r = 0; r < 16; ++r) { p0[r] = __builtin_amdgcn_exp2f(fmaf(p0[r], CL2, mnC)); p1[r] = __builtin_amdgcn_exp2f(fmaf(p1[r], CL2, mnC)); ps += p0[r] + p1[r]; }
    ps = swap_sum(ps);
    l_reg = l_reg * alpha + ps;
    if (__any(alpha < 1.f)) { if (hi == 0) al_l[r32] = alpha; asm volatile("s_waitcnt lgkmcnt(0)" ::: "memory");
#pragma unroll
        for (int r = 0; r < 16; ++r) { const float a = al_l[crow(r, hi)];
#pragma unroll
            for (int d = 0; d < 4; ++d) o[d][r] *= a; } }
    bf16x8 pa0, pa1, pa2, pa3; pack_p(p0, p1, pa0, pa1, pa2, pa3);
    pv_d0(o, vb, pa0, pa1, pa2, pa3);
}

__device__ __forceinline__ void att_V(f32x16& p0, f32x16& p1, float& m_reg, float& l_reg, float& alpha, bf16x8& pa0, bf16x8& pa1, bf16x8& pa2, bf16x8& pa3, int hi, bool rowok, int mode, int lim) {
    const float NINF = -__builtin_inff();
    int limh = lim - 4 * hi; asm volatile("" : "+v"(limh));
    if (mode == 1) {
#pragma unroll
        for (int r = 0; r < 16; ++r) { const int k = ((r & 3) + 8 * (r >> 2)); if (k > limh) p0[r] = NINF; if (k + 32 > limh) p1[r] = NINF; } }
    else if (mode == 2) {
#pragma unroll
        for (int r = 0; r < 16; ++r) { const int k = ((r & 3) + 8 * (r >> 2)); if (k <= limh) p0[r] = NINF; if (k + 32 <= limh) p1[r] = NINF; } }
    float pmax = p0[0];
#pragma unroll
    for (int r = 1; r < 16; ++r) pmax = fmaxf(pmax, p0[r]);
#pragma unroll
    for (int r = 0; r < 16; ++r) pmax = fmaxf(pmax, p1[r]);
    pmax = swap_max(pmax);
    if (!rowok) pmax = NINF;
    float mn;
    if (__all(pmax - m_reg <= THR / SCALE)) { mn = m_reg; alpha = 1.f; }
    else { mn = fmaxf(m_reg, pmax); alpha = __builtin_amdgcn_exp2f((m_reg - mn) * CL2); m_reg = mn; }
    const float mnC = rowok ? -mn * CL2 : NINF;
    float s = 0.f;
#pragma unroll
    for (int r = 0; r < 16; ++r) { p0[r] = __builtin_amdgcn_exp2f(fmaf(p0[r], CL2, mnC)); p1[r] = __builtin_amdgcn_exp2f(fmaf(p1[r], CL2, mnC)); s += p0[r] + p1[r]; }
    l_reg = l_reg * alpha + swap_sum(s);
    pack_p(p0, p1, pa0, pa1, pa2, pa3);
}
__device__ __forceinline__ void att_PV(float alpha, f32x16* o, int vb, bf16x8 pa0, bf16x8 pa1, bf16x8 pa2, bf16x8 pa3, LAS float* al_l, int r32, int hi) {
    if (__any(alpha < 1.f)) { if (hi == 0) al_l[r32] = alpha; asm volatile("s_waitcnt lgkmcnt(0)" ::: "memory");
#pragma unroll
        for (int r = 0; r < 16; ++r) { const float a = al_l[crow(r, hi)];
#pragma unroll
            for (int d = 0; d < 4; ++d) o[d][r] *= a; } }
    pv_pipe(o, vb, pa0, pa1, pa2, pa3);
}

__device__ __forceinline__ float gate_val(const float* GN, int gidx, int br) {
    asm volatile("" : "+v"(gidx));
    const float* p = GN + (size_t)gidx + br * 16;
    return sigmoidf_((p[0] + p[(size_t)M * 64]) + (p[(size_t)2 * M * 64] + p[(size_t)3 * M * 64]));
}
template <int TRAIL> __device__ __forceinline__ void attn_unit(Frame& F, int b, int g, int cur) {
    const float NINF = -__builtin_inff();
    const int wid = F.wave, lane = lane_id_v(), tid = wid * 64 + lane, r32 = lane & 31, hi = lane >> 5;
    LAS unsigned char* lds = F.lds;
    LAS float* wsf = (LAS float*)(lds + L_WS + wid * WSB);
    LAS float* li_l = wsf; LAS float* al_l = wsf + 32; LAS float* impA = wsf + 64; LAS float* impE = wsf + 64 + 512; LAS unsigned* mskl = (LAS unsigned*)(wsf + 64 + 512 + 544);
    const int trel = 8 * wid + (r32 >> 2), head = r32 & 3, t0 = 64 * cur, tq = t0 + trel;
    const size_t tokq = (size_t)b * SEQ + tq;
    const bf16_t* Qb = (const bf16_t*)(F.ws + WS_Q); const bf16_t* KVb = (const bf16_t*)(F.ws + WS_KV); const bf16_t* KC = (const bf16_t*)(F.ws + WS_KC);
    const float* GN = (const float*)(F.ws + WS_GN);
    float* ACC = (float*)(F.ws + WS_ACC) + (size_t)blockIdx.x * (256 * 128);
    bf16x8 qr[8];
    { const bf16_t* Qw = Qb + tokq * 2048 + (g * 4 + head) * 128 + hi * 8;
#pragma unroll
      for (int d0 = 0; d0 < 8; ++d0) qr[d0] = *(const bf16x8*)(Qw + d0 * 16); }
    const int gidx0 = (int)(tokq * 64) + g * 4 + head;
#define GATE(br) gate_val(GN, gidx0, (br))
    const int sr0 = tid >> 4, sc0 = (tid & 15) * 8;
    const int vbase = (int)(unsigned)(uintptr_t)(lds + L_V) + v_rd_base(lane);
#define KIDX(r) (((r) & 3) + 8 * ((r) >> 2))
    f32x16 o[4]; f32x16 p0, p1; Stg stg;

#define TILE_LOOP(NT, KPTR, VPTR, LD, WITHV, ...) do { int sr = sr0, sc = sc0; asm volatile("" : "+v"(sr), "+v"(sc)); \
        { const int i = 0; gload<WITHV>(stg, KPTR, VPTR, LD, sr, sc); } lwrite<WITHV>(lds, 0, stg, sr, sc); __syncthreads(); \
        for (int i_ = 0; i_ < (NT); ++i_) { const int buf = i_ & 1; \
            if (i_ + 1 < (NT)) { const int i = i_ + 1; gload<WITHV>(stg, KPTR, VPTR, LD, sr, sc); } \
            { const int i = i_; __VA_ARGS__ } \
            if (i_ + 1 < (NT)) lwrite<WITHV>(lds, buf ^ 1, stg, sr, sc); \
            __syncthreads(); } } while (0)
#define HBAR() do { asm volatile("s_waitcnt lgkmcnt(0)" ::: "memory"); __builtin_amdgcn_s_barrier(); asm volatile("" ::: "memory"); } while (0)
#define GLK(i) do { stg.k0 = *(const bf16x8*)(KPTR_(i) + (size_t)sr * LD_ + sc); stg.k1 = *(const bf16x8*)(KPTR_(i) + (size_t)(32 + sr) * LD_ + sc); } while (0)
#define GLV(i) do { stg.k0 = *(const bf16x8*)(VPTR_(i) + (size_t)sr * LD_ + sc); stg.k1 = *(const bf16x8*)(VPTR_(i) + (size_t)(32 + sr) * LD_ + sc); } while (0)
#define WRK(buf) do { *(LAS bf16x8*)(lds + L_K + (buf) * KVT + KSWZ(sr, sc * 2)) = stg.k0; *(LAS bf16x8*)(lds + L_K + (buf) * KVT + KSWZ(32 + sr, sc * 2)) = stg.k1; } while (0)
#define WRV(buf) do { *(LAS bf16x8*)(lds + L_V + (buf) * KVT + v_st(sr, sc)) = stg.k0; *(LAS bf16x8*)(lds + L_V + (buf) * KVT + v_st(32 + sr, sc)) = stg.k1; } while (0)
#define SHIFT_LOOP_D(D, NT, MCALL, VCALL) do { int sr = sr0, sc = sc0; asm volatile("" : "+v"(sr), "+v"(sc)); const int nt_ = (NT); \
        GLK(0); stg.v0 = *(const bf16x8*)(VPTR_(0) + (size_t)sr * LD_ + sc); stg.v1 = *(const bf16x8*)(VPTR_(0) + (size_t)(32 + sr) * LD_ + sc); WRK(0); \
        *(LAS bf16x8*)(lds + L_V + v_st(sr, sc)) = stg.v0; *(LAS bf16x8*)(lds + L_V + v_st(32 + sr, sc)) = stg.v1; HBAR(); \
        for (int m_ = 0; m_ <= nt_; ++m_) { \
            if (m_ + 1 < nt_) GLK(m_ + 1); \
            if (D == 0) { const int i = m_; MCALL; } else if (m_ >= 1) { const int i = m_ - 1; VCALL; } \
            if (m_ + 1 < nt_) WRK((m_ + 1) & 1); \
            HBAR(); \
            if (m_ >= 1 && m_ < nt_) GLV(m_); \
            if (D == 0) { if (m_ < nt_) { const int i = m_; VCALL; } } else { const int i = m_; MCALL; } \
            if (m_ >= 1 && m_ < nt_) WRV(m_ & 1); \
            HBAR(); } } while (0)
#define SHIFT_LOOP(NT, MCALL, VCALL) SHIFT_LOOP_D(TRAIL, NT, MCALL, VCALL)
#define STORE_SCALED(FIRST, LAST, SCALE_ROW) do { \
        if (hi == 0) li_l[r32] = (SCALE_ROW); asm volatile("s_waitcnt lgkmcnt(0)" ::: "memory"); \
        int hh = hi, cc = r32; asm volatile("" : "+v"(hh), "+v"(cc)); \
        float* accb = ACC + (size_t)(wid * 32 + 4 * hh) * 128 + cc; \
        bf16_t* yb = (bf16_t*)(F.ws + WS_YAB) + ((size_t)b * SEQ + t0 + 8 * wid + hh) * 4096 + 2048 + g * 512 + cc; \
        _Pragma("unroll") for (int rh = 0; rh < 2; ++rh) { float prev_[8][4]; \
            if (!(FIRST)) { _Pragma("unroll") for (int r8 = 0; r8 < 8; ++r8) { const int r = rh * 8 + r8; _Pragma("unroll") for (int d0 = 0; d0 < 4; ++d0) prev_[r8][d0] = accb[((r & 3) + 8 * (r >> 2)) * 128 + d0 * 32]; } } \
            _Pragma("unroll") for (int r8 = 0; r8 < 8; ++r8) { const int r = rh * 8 + r8; const float scl = li_l[(r & 3) + 8 * (r >> 2) + 4 * hh]; \
                _Pragma("unroll") for (int d0 = 0; d0 < 4; ++d0) { float v = o[d0][r] * scl; \
                    if (!(FIRST)) v += prev_[r8][d0]; \
                    if (LAST) yb[(size_t)(2 * (r >> 2)) * 4096 + (r & 3) * 128 + d0 * 32] = (bf16_t)f2bf(v); \
                    else accb[((r & 3) + 8 * (r >> 2)) * 128 + d0 * 32] = v; } } \
            asm volatile("" ::: "memory"); } } while (0)

    const int ntc = ((4 * cur + 2) >> 6) + 1;
    const int nmax = (tq - 31) >> 4;
    const bf16_t* KCk = KC + (size_t)(b * 4 + g) * 256 * 128; const bf16_t* KCv = KCk + (size_t)16 * 256 * 128;
    float m_c = -1e30f, l_c = 0.f;
    {
        int sr = sr0, sc = sc0; asm volatile("" : "+v"(sr), "+v"(sc));
        bf16x8 ka[4], kb[4];
#pragma unroll
        for (int jt = 0; jt < 4; ++jt) if (jt < ntc) { ka[jt] = *(const bf16x8*)(KCk + (size_t)(jt * 64 + sr) * 128 + sc); kb[jt] = *(const bf16x8*)(KCk + (size_t)(jt * 64 + 32 + sr) * 128 + sc); }
#pragma unroll
        for (int jt = 0; jt < 4; ++jt) if (jt < ntc) { *(LAS bf16x8*)(lds + jt * KVT + KSWZ(sr, sc * 2)) = ka[jt]; *(LAS bf16x8*)(lds + jt * KVT + KSWZ(32 + sr, sc * 2)) = kb[jt]; }
        __syncthreads();
        for (int jt = 0; jt < ntc; ++jt) {
            qkt(p0, p1, lds + jt * KVT, qr, r32, hi);
            int lim = nmax - 64 * jt - 4 * hi; asm volatile("" : "+v"(lim));
            float pmax = NINF;
#pragma unroll
            for (int r = 0; r < 16; ++r) { if (KIDX(r) > lim) p0[r] = NINF; if (KIDX(r) + 32 > lim) p1[r] = NINF; pmax = fmaxf(pmax, fmaxf(p0[r], p1[r])); }
            pmax = swap_max(pmax);
            const float mn = fmaxf(m_c, pmax), mnC = -mn * CL2; float ps = 0.f;
#pragma unroll
            for (int r = 0; r < 16; ++r) ps += __builtin_amdgcn_exp2f(fmaf(p0[r], CL2, mnC)) + __builtin_amdgcn_exp2f(fmaf(p1[r], CL2, mnC));
            ps = swap_sum(ps);
            l_c = l_c * __builtin_amdgcn_exp2f((m_c - mn) * CL2) + ps; m_c = mn;
        }
        __syncthreads();
    }
    const float rl_c = l_c > 0.f ? 1.0f / l_c : 0.f, mcC = -m_c * CL2;
    const bool need_topk = cur >= 16;
    if (need_topk) { for (int q = lane; q < 512 + 544; q += 64) impA[q] = 0.f; }
#pragma unroll
    for (int d = 0; d < 4; ++d) o[d] = f32x16{};
    TILE_LOOP(ntc, KCk + (size_t)i * 64 * 128, KCv + (size_t)i * 64 * 128, 128, true, {
        qkt(p0, p1, lds + L_K + buf * KVT, qr, r32, hi);
        int lim = nmax - 64 * i - 4 * hi; asm volatile("" : "+v"(lim));
        _Pragma("unroll") for (int r = 0; r < 16; ++r) {
            p0[r] = (KIDX(r) > lim) ? 0.f : __builtin_amdgcn_exp2f(fmaf(p0[r], CL2, mcC)) * rl_c;
            p1[r] = (KIDX(r) + 32 > lim) ? 0.f : __builtin_amdgcn_exp2f(fmaf(p1[r], CL2, mcC)) * rl_c; }
        if (need_topk) {
            _Pragma("unroll") for (int a = 0; a < 4; ++a) {
                float s4 = (p0[4 * a] + p0[4 * a + 1]) + (p0[4 * a + 2] + p0[4 * a + 3]), e = p0[4 * a + 3];
                float s4b = (p1[4 * a] + p1[4 * a + 1]) + (p1[4 * a + 2] + p1[4 * a + 3]), eb = p1[4 * a + 3];
                s4 += __shfl_xor(s4, 1); s4 += __shfl_xor(s4, 2); e += __shfl_xor(e, 1); e += __shfl_xor(e, 2);
                s4b += __shfl_xor(s4b, 1); s4b += __shfl_xor(s4b, 2); eb += __shfl_xor(eb, 1); eb += __shfl_xor(eb, 2);
                if (head == 0) { const int j = 16 * i + 2 * a + hi, tk8 = r32 >> 2;
                    impA[tk8 * 64 + j] = s4; impE[tk8 * 68 + j + 1] = e; impA[tk8 * 64 + j + 8] = s4b; impE[tk8 * 68 + j + 9] = eb; } } }
        bf16x8 pa0, pa1, pa2, pa3; pack_p(p0, p1, pa0, pa1, pa2, pa3);
        pv_d0(o, vbase + buf * KVT, pa0, pa1, pa2, pa3);
    });
    STORE_SCALED(true, false, GATE(0));
    unsigned mlo, mhi;
    if (need_topk) {
        asm volatile("s_waitcnt lgkmcnt(0)" ::: "memory");
        LAS unsigned* keys = (LAS unsigned*)impA;
#pragma unroll
        for (int k = 0; k < 8; ++k) { const bool cand = lane >= 1 && lane <= cur - 2;
            const unsigned key = cand ? ((__float_as_uint(impA[k * 64 + lane] + impE[k * 68 + lane]) & ~63u) | (unsigned)(63 - lane)) : 0u;
            keys[k * 64 + lane] = key; }
        asm volatile("s_waitcnt lgkmcnt(0)" ::: "memory");
        const int tk = lane >> 3, s8 = lane & 7;
        const u32x4 ka = *(const LAS u32x4*)(keys + tk * 64 + s8 * 8), kb = *(const LAS u32x4*)(keys + tk * 64 + s8 * 8 + 4);
        const unsigned my[8] = {ka.x, ka.y, ka.z, ka.w, kb.x, kb.y, kb.z, kb.w};
        int cnt[8] = {0, 0, 0, 0, 0, 0, 0, 0};
#pragma unroll 4
        for (int j4 = 0; j4 < 16; ++j4) { const u32x4 x = *(const LAS u32x4*)(keys + tk * 64 + j4 * 4);
#pragma unroll
            for (int i = 0; i < 8; ++i) cnt[i] += (int)(x.x > my[i]) + (int)(x.y > my[i]) + (int)(x.z > my[i]) + (int)(x.w > my[i]); }
        unsigned byte = 0;
#pragma unroll
        for (int i = 0; i < 8; ++i) byte |= ((my[i] != 0u && cnt[i] < 13) ? 1u : 0u) << i;
        ((LAS unsigned char*)mskl)[tk * 8 + s8] = (unsigned char)byte;
        asm volatile("s_waitcnt lgkmcnt(0)" ::: "memory");
        const unsigned long long forced = 1ull | (1ull << cur) | (1ull << (cur - 1));
        mlo = mskl[2 * (r32 >> 2)] | (unsigned)forced; mhi = mskl[2 * (r32 >> 2) + 1] | (unsigned)(forced >> 32);
    } else { const unsigned long long bal = (2ull << cur) - 1ull; mlo = (unsigned)bal; mhi = (unsigned)(bal >> 32); }
    if (TRAIL) __builtin_amdgcn_s_setprio(1);
    float alpha_ = 1.f; bool act_ = false; bf16x8 pa0, pa1, pa2, pa3;
    {
        const bf16_t* Kp = KVb + (size_t)2 * M * 512 + (size_t)b * SEQ * 512 + g * 128; const bf16_t* Vp = KVb + (size_t)3 * M * 512 + (size_t)b * SEQ * 512 + g * 128;
        float m_reg = -1e30f, l_reg = 0.f;
#pragma unroll
        for (int d = 0; d < 4; ++d) o[d] = f32x16{};
#define KPTR_(i) (Kp + (size_t)(i) * 64 * 512)
#define VPTR_(i) (Vp + (size_t)(i) * 64 * 512)
#define LD_ 512
#define SELB(i) ((((i) < 32 ? (mlo >> (i)) : (mhi >> ((i) - 32))) & 1u) != 0u)
        SHIFT_LOOP(cur + 1,
            { if (i >= 1 && act_) att_PV(alpha_, o, vbase + ((i - 1) & 1) * KVT, pa0, pa1, pa2, pa3, al_l, r32, hi);
              if (i <= cur) { act_ = __any(SELB(i)); if (act_) qkt_pipe(p0, p1, lds + L_K + (i & 1) * KVT, qr, r32, hi); else { p0 = f32x16{}; p1 = f32x16{}; } } },
            { if (act_) att_V(p0, p1, m_reg, l_reg, alpha_, pa0, pa1, pa2, pa3, hi, SELB(i), (i == cur) ? 1 : 0, trel); else { pa0 = bf16x8{}; pa1 = bf16x8{}; pa2 = bf16x8{}; pa3 = bf16x8{}; } });
#undef SELB
#undef KPTR_
#undef VPTR_
        STORE_SCALED(false, false, (l_reg > 0.f ? GATE(1) / l_reg : 0.f));
    }
    {
        const bf16_t* Kp = KVb + (size_t)4 * M * 512 + (size_t)b * SEQ * 512 + g * 128; const bf16_t* Vp = KVb + (size_t)5 * M * 512 + (size_t)b * SEQ * 512 + g * 128;
        float m_reg = -1e30f, l_reg = 0.f;
        const int ntw = (cur < 8 ? cur : 8) + 1;
#pragma unroll
        for (int d = 0; d < 4; ++d) o[d] = f32x16{};
#define KPTR_(i) (Kp + (size_t)(cur - (i)) * 64 * 512)
#define VPTR_(i) (Vp + (size_t)(cur - (i)) * 64 * 512)
        SHIFT_LOOP(ntw,
            { if (i >= 1) att_PV(alpha_, o, vbase + ((i - 1) & 1) * KVT, pa0, pa1, pa2, pa3, al_l, r32, hi);
              if (i < ntw) qkt_pipe(p0, p1, lds + L_K + (i & 1) * KVT, qr, r32, hi); },
            { att_V(p0, p1, m_reg, l_reg, alpha_, pa0, pa1, pa2, pa3, hi, true, (i == 0) ? 1 : ((i == 8) ? 2 : 0), trel); });
#undef KPTR_
#undef VPTR_
#undef LD_
        if (TRAIL) __builtin_amdgcn_s_setprio(0);
        STORE_SCALED(false, true, (l_reg > 0.f ? GATE(2) / l_reg : 0.f));
    }
#undef SHIFT_LOOP
#undef SHIFT_LOOP_D
#undef HBAR
#undef GLK
#undef GLV
#undef WRK
#undef WRV
#undef TILE_LOOP
#undef STORE_SCALED
#undef GATE
#undef KIDX
}
}

__device__ __forceinline__ void row_pass1(Frame& F) {
    const int gw = F.vcu * NWAVES + F.wave, NGW = F.G * NWAVES;
    const bf16_t* O = (const bf16_t*)(F.ws + WS_O); const float* SS = (const float*)(F.ws + WS_SS1);
    const GAS f32x4* g1 = (const GAS f32x4*)F.in[I_NMIXPOST]; const GAS f32x4* g2 = (const GAS f32x4*)F.in[I_NFFNPRE];
    for (int m = gw; m < M; m += NGW) {
        const float ss = wave_sum(SS[(size_t)m * 64 + F.lane]);
        const float r1 = 1.0f / sqrtf(ss * (1.f / DM) + RMS_EPS);
        const GAS u32x2* orow = (const GAS u32x2*)(O + (size_t)m * DM) + F.lane; const GAS f32x4* xrow = (const GAS f32x4*)(F.in[I_X] + (size_t)m * DM) + F.lane;
        GAS u32x2* hrow = (GAS u32x2*)((bf16_t*)(F.ws + WS_H1B) + (size_t)m * DM) + F.lane;
        f32x4 h[16]; float s2 = 0.f;
#pragma unroll
        for (int j = 0; j < 16; ++j) { const u32x2 ob = __builtin_nontemporal_load((const u32x2*)&orow[64 * j]); const f32x4 ov = {bf_lo(ob.x), bf_hi(ob.x), bf_lo(ob.y), bf_hi(ob.y)}, xv = __builtin_nontemporal_load((const f32x4*)&xrow[64 * j]), gv = g1[64 * j + F.lane]; h[j] = xv + ov * r1 * gv; { u32x2 hw; hw.x = cvt_pk_bf16(h[j].x, h[j].y); hw.y = cvt_pk_bf16(h[j].z, h[j].w); __builtin_nontemporal_store(hw, (u32x2*)&hrow[64 * j]); }
            s2 += (h[j].x * h[j].x + h[j].y * h[j].y) + (h[j].z * h[j].z + h[j].w * h[j].w); }
        const float r2 = 1.0f / sqrtf(wave_sum(s2) * (1.f / DM) + RMS_EPS);
        GAS u32x2* o8 = (GAS u32x2*)((bf16_t*)(F.ws + WS_HN) + (size_t)m * DM) + F.lane;
#pragma unroll
        for (int j = 0; j < 16; ++j) { const f32x4 gv = g2[64 * j + F.lane]; u32x2 w; w.x = pk2(h[j].x * r2 * gv.x, h[j].y * r2 * gv.y); w.y = pk2(h[j].z * r2 * gv.z, h[j].w * r2 * gv.w); o8[64 * j] = w; }
    }
}
__device__ __forceinline__ void row_pass2(Frame& F) {
    const int gw = F.vcu * NWAVES + F.wave, NGW = F.G * NWAVES;
    const bf16_t* Fm = (const bf16_t*)(F.ws + WS_F); const float* SS = (const float*)(F.ws + WS_SS2);
    const GAS f32x4* g1 = (const GAS f32x4*)F.in[I_NFFNPOST] + F.lane;
    u32x2 fa[16], ha[16], fb[16], hb[16]; float sa, sb;
#define RP_LOAD(FB, HB, SV, m) do { const GAS u32x2* frow = (const GAS u32x2*)(Fm + (size_t)(m) * DM) + F.lane; const GAS u32x2* hrow = (const GAS u32x2*)((const bf16_t*)(F.ws + WS_H1B) + (size_t)(m) * DM) + F.lane; \
        SV = SS[(size_t)(m) * 64 + F.lane]; _Pragma("unroll") for (int j = 0; j < 16; ++j) { FB[j] = __builtin_nontemporal_load((const u32x2*)&frow[64 * j]); HB[j] = __builtin_nontemporal_load((const u32x2*)&hrow[64 * j]); } } while (0)
#define RP_PROC(FB, HB, SV, m) do { const float r1 = 1.0f / sqrtf(wave_sum(SV) * (1.f / DM) + RMS_EPS); GAS f32x4* orow = (GAS f32x4*)(F.out + (size_t)(m) * DM) + F.lane; \
        _Pragma("unroll") for (int j = 0; j < 16; ++j) { const f32x4 fv = {bf_lo(FB[j].x), bf_hi(FB[j].x), bf_lo(FB[j].y), bf_hi(FB[j].y)}, hv = {bf_lo(HB[j].x), bf_hi(HB[j].x), bf_lo(HB[j].y), bf_hi(HB[j].y)}, gv = g1[64 * j]; \
            __builtin_nontemporal_store(hv + fv * r1 * gv, (f32x4*)&orow[64 * j]); } } while (0)
    int m = gw;
    if (m < M) RP_LOAD(fa, ha, sa, m);
    for (; m < M; m += 2 * NGW) {
        const int m1 = m + NGW, m2 = m + 2 * NGW;
        if (m1 < M) RP_LOAD(fb, hb, sb, m1);
        RP_PROC(fa, ha, sa, m);
        if (m1 < M) { if (m2 < M) RP_LOAD(fa, ha, sa, m2); RP_PROC(fb, hb, sb, m1); }
    }
#undef RP_LOAD
#undef RP_PROC
}

struct OrdCmp {
    const char* KVb; const char* W1T; int G, c;
    __device__ __forceinline__ bool next(int i, pg8::GUnit& u) const {
        const int L = i * G + c; if (L >= 256) return false;
        const int slab = L & 7, pm = L >> 3, kv = pm >> 4, bg = pm & 15, b = bg >> 2, g = bg & 3, h = slab >> 2, lq = slab & 3;
        u.a = KVb + ((size_t)kv * M * 512 + (size_t)b * SEQ * 512 + g * 128 + h * 64 + (size_t)lq * 8 * 512) * 2;
        u.b = W1T + ((size_t)kv * 128 * 4096 + h * 2048 + lq * 512) * 2; u.pm = pm; u.pn = slab; return true;
    }
};

struct Args { const float* in[N_IN]; float* out; unsigned char* ws; int ph_lo, ph_hi; };
constexpr int N_PHASES = 12;
__global__ void __launch_bounds__(NWAVES * 64, 2) hybrid_fwd(Args args) {
    extern __shared__ __attribute__((aligned(16))) unsigned char lds_raw[];
    Frame F;
    F.lds = (LAS unsigned char*)lds_raw;
    F.wave = __builtin_amdgcn_readfirstlane(threadIdx.x >> 6); F.lane = lane_id_v(); F.tid = F.wave * 64 + F.lane;
    F.G = gridDim.x; { const int bx = blockIdx.x; F.vcu = (F.G % 8 == 0) ? (bx % 8) * (F.G / 8) + bx / 8 : bx; }
    F.in = args.in; F.ws = args.ws; F.out = args.out;
    unsigned char* ws = args.ws;
    for (int u = F.tid; u < (LDS_BYTES - LDSCTL_OFF) / 4; u += NWAVES * 64) ((LAS unsigned*)(F.lds + LDSCTL_OFF))[u] = 0u;
    __syncthreads();
#if MK_PER_PHASE
#define GRID_BAR() do { } while (0)
#else
    XcdBarrier bar = xcd_barrier_post((unsigned*)(ws + WS_CTL) + CW_BAR, (volatile LAS unsigned*)(F.lds + MISC_OFF) + 8);
#define GRID_BAR() xcd_barrier(bar)
#endif
    const int lo = args.ph_lo, hi = args.ph_hi;
#ifndef PH_MASK
#define PH_MASK 0xFFFF
#endif
#define IN(k) ((((PH_MASK) >> (k)) & 1) && lo <= (k) && (k) < hi)
#define BOTH(k) (IN(k) && IN((k) + 1))
    const int bx = (int)blockIdx.x;
#define REFRESH() do { F.lane = lane_id_v(); F.tid = F.wave * 64 + F.lane; } while (0)
    if (IN(0)) { REFRESH(); p0_prologue(F); if (BOTH(0)) GRID_BAR(); }
    if (IN(1)) {
        pg8::Geo g{8192, 8192, 128, 128, (size_t)128 * 8192, (size_t)128 * 8192, 64};
        pg8::OrdStd S; S.init(ws + WS_HN, ws + WS_WIN, (size_t)256 * 8192, 0, (size_t)256 * 8192, 64, 28, F.G, bx);
        pg8::EpiInProj E{0, (bf16_t*)(ws + WS_UH), (bf16_t*)(ws + WS_Q), (bf16_t*)(ws + WS_KV), (bf16_t*)(ws + WS_GA), (bf16_t*)(ws + WS_GB)};
        pg8::gemm_phase(F.lds, g, S, E);
        {
            pg8::Geo g8{4096, 4096, 128, 128, (size_t)128 * 4096, (size_t)128 * 4096, 32};
            pg8::OrdStd S8; S8.init(ws + WS_HN8, ws + WS_WG8, (size_t)256 * 4096, 0, (size_t)256 * 4096, 64, 32, F.G, bx);
            pg8::EpiGate8 E8{0, (unsigned char*)(ws + WS_GA), (unsigned char*)(ws + WS_GB), 1.0f / GATE_WSCALE};
            pg8::gemm_phase<pg8::EpiGate8, pg8::OrdStd, true>(F.lds, g8, S8, E8);
        }
        if (BOTH(1)) GRID_BAR();
    }
    if (IN(2)) {
        { pg8::Geo g{8192, 8192, 128, 128, (size_t)128 * 8192, (size_t)128 * 8192, 16};
          pg8::OrdStd S; S.init(ws + WS_HN, ws + WS_WGN, (size_t)256 * 8192, 2048, 2048, 64, 4, F.G, bx);
          pg8::EpiF32Part E{0, (float*)(ws + WS_GN), (size_t)M * 64, 64, 64, 256};
          pg8::gemm_phase(F.lds, g, S, E); }
        { pg8::Geo g{16384, 8192, 1024, 128, (size_t)128 * 16384, 0, 8};
          OrdCmp S{(const char*)(ws + WS_KV), (const char*)(ws + WS_W1T), F.G, bx};
          pg8::EpiF32Part E{0, (float*)(ws + WS_CP), (size_t)8192 * 128, 128, 128, 256};
          pg8::gemm_phase(F.lds, g, S, E); }
        { pg8::Geo g{768, 512, 128, 128, (size_t)128 * 768, 0, 4};
          OrdS5 S{(const char*)(ws + WS_UH), (const char*)(ws + WS_STT), (size_t)128 * 256 * 2, F.G, bx};
          pg8::EpiBf16Part E{0, (bf16_t*)(ws + WS_HC), 128, 128, 256};
          pg8::gemm_phase(F.lds, g, S, E); }
        if (BOTH(2)) GRID_BAR();
    }
    if (IN(3)) { REFRESH(); s5_scan(F); compress2(F);
        {
            const int first = (F.G >= 256) ? 64 : 0, nconv = F.G - first, myc = F.vcu - first;
            if (myc >= 0) { LAS float* scr = (LAS float*)(F.lds + F.wave * 16384);
                constexpr int J_GLU = (2048 / 64) * (2048 / 32), J_PA = (2048 / 64) * (4096 / 32), J_OUT = (4096 / 64) * (4096 / 32);
                for (int it = myc * NWAVES + F.wave; it < J_GLU + 2 * J_PA + J_OUT; it += nconv * NWAVES) { int r = it;
                    if (r < J_GLU) { const int nb = r % 64, kb = r / 64; p0_tr_item(F.in[I_WGLU], 2048, kb * 64, nb * 32, (bf16_t*)(ws + WS_WGLU), 2048, nb * 32, kb * 64, scr, F.lane); continue; } r -= J_GLU;
                    if (r < J_PA) { const int nb = r % 128, kb = r / 128; p0_tr_item(F.in[I_WPA], 4096, kb * 64, nb * 32, (bf16_t*)(ws + WS_WAB), 4096, nb * 32, kb * 64, scr, F.lane); continue; } r -= J_PA;
                    if (r < J_PA) { const int nb = r % 128, kb = r / 128; p0_tr_item(F.in[I_WPB], 4096, kb * 64, nb * 32, (bf16_t*)(ws + WS_WAB), 4096, nb * 32, 2048 + kb * 64, scr, F.lane); continue; } r -= J_PA;
                    { const int nb = r % 128, kb = r / 128; p0_tr_item(F.in[I_WOUT], 4096, kb * 64, nb * 32, (bf16_t*)(ws + WS_WOUT), 4096, nb * 32, kb * 64, scr, F.lane); } } }
        }
        if (BOTH(3)) GRID_BAR(); }
    if (IN(4)) {
        for (int k = F.vcu; k < 256; k += F.G) {
            const int bg = k >> 4, i = k & 15;
            const int curs[4] = {i, 31 - i, 32 + i, 63 - i};
#pragma unroll 1
            for (int q = 0; q < 4; ++q) { const int cur = (q == 0) ? 63 - i : (q == 1) ? 32 + i : (q == 2) ? 31 - i : i;
                if (F.wave < 4) att::attn_unit<0>(F, bg >> 2, bg & 3, cur); else att::attn_unit<1>(F, bg >> 2, bg & 3, cur); }
            (void)curs;
        }
        { pg8::Geo g{768, 768, 128, 128, (size_t)128 * 768, (size_t)128 * 768, 6};
          OrdS5 S{(const char*)(ws + WS_UH), (const char*)(ws + WS_TGT), (size_t)256 * 384 * 2, F.G, bx};
          pg8::EpiS5Y E{0, (bf16_t*)(ws + WS_Y)};
          pg8::gemm_phase(F.lds, g, S, E); }
        if (BOTH(4)) GRID_BAR();
    }
    if (IN(5)) {
        pg8::Geo g{4096, 4096, 128, 128, (size_t)128 * 4096, (size_t)128 * 4096, 32};
        pg8::OrdStd S; S.init(ws + WS_Y, ws + WS_WGLU, (size_t)256 * 4096, 0, (size_t)256 * 4096, 64, 8, F.G, bx);
        pg8::EpiGlu E{0, (const bf16_t*)(ws + WS_Y), F.in[I_BGLU], (bf16_t*)(ws + WS_YAB)};
        pg8::gemm_phase(F.lds, g, S, E);
        if (BOTH(5)) GRID_BAR();
    }
    if (IN(6)) {
        pg8::Geo g{8192, 8192, 128, 128, (size_t)128 * 8192, (size_t)128 * 8192, 64};
        pg8::OrdStd S; S.init(ws + WS_YAB, ws + WS_WAB, (size_t)256 * 8192, 0, (size_t)256 * 8192, 64, 16, F.G, bx);
        pg8::EpiMerge E{32, (const unsigned char*)(ws + WS_GA), (const unsigned char*)(ws + WS_GB), (bf16_t*)(ws + WS_MRG)};
        pg8::gemm_phase(F.lds, g, S, E);
        if (BOTH(6)) GRID_BAR();
    }
    if (IN(7)) {
        pg8::Geo g{8192, 8192, 128, 128, (size_t)128 * 8192, (size_t)128 * 8192, 64};
        pg8::OrdStd S; S.init(ws + WS_MRG, ws + WS_WOUT, (size_t)256 * 8192, 0, (size_t)256 * 8192, 64, 16, F.G, bx);
        pg8::EpiBf16SS E{0, (bf16_t*)(ws + WS_O), (float*)(ws + WS_SS1)};
        pg8::gemm_phase(F.lds, g, S, E);
        if (BOTH(7)) GRID_BAR();
    }
    if (IN(8)) { REFRESH(); row_pass1(F); if (BOTH(8)) GRID_BAR(); }
    if (IN(9)) {
        pg8::Geo g{8192, 8192, 128, 128, (size_t)128 * 8192, (size_t)128 * 8192, 64};
        pg8::OrdStd S; S.init(ws + WS_HN, ws + WS_WGU, (size_t)256 * 8192, 0, (size_t)256 * 8192, 64, 86, F.G, bx);
        pg8::EpiSwiGlu E{0, (bf16_t*)(ws + WS_A2)};
        pg8::gemm_phase(F.lds, g, S, E);
        {
            const int nun = 64 * 86, rounds = (nun + F.G - 1) / F.G, first_idle = nun - (rounds - 1) * F.G;
            const int nconv = (first_idle < F.G) ? F.G - first_idle : F.G, myc = (first_idle < F.G) ? bx - first_idle : bx;
            if (myc >= 0) { REFRESH(); LAS float* scr = (LAS float*)(F.lds + F.wave * 16384);
                for (int it = myc * NWAVES + F.wave; it < (DFF / 64) * 128; it += nconv * NWAVES) { const int nb = it % 128, kb = it / 128;
                    p0_tr_item(F.in[I_WDOWN], 4096, kb * 64, nb * 32, (bf16_t*)(ws + WS_WDN) + ((size_t)(nb >> 3) * (DFF / 64) + kb) * 16384, 64, (nb & 7) * 32, 0, scr, F.lane); } }
        }
        if (BOTH(9)) GRID_BAR();
    }
    if (IN(10)) {
        pg8::Geo g{128, 128, 32768, 32768, 16384, 16384, DFF / 64};
        pg8::OrdStd S; S.init(ws + WS_A2, ws + WS_WDN, (size_t)(DFF / 64) * 32768, 0, (size_t)(DFF / 64) * 32768, 64, 16, F.G, bx, 4);
        pg8::EpiBf16SS E{0, (bf16_t*)(ws + WS_F), (float*)(ws + WS_SS2)};
        pg8::gemm_phase(F.lds, g, S, E);
        if (BOTH(10)) GRID_BAR();
    }
    if (IN(11)) { REFRESH(); row_pass2(F); }
#undef IN
#undef BOTH
}

extern "C" void kernel_launch(void* const* d_in, const int* in_sizes, int n_in, void* d_out, int out_size, void* d_ws, size_t ws_size, hipStream_t stream) {
    static int grid = 0;
    if (grid == 0) {
        if (n_in != N_IN || in_sizes[0] != M * DM || out_size != M * DM || ws_size < WS_END) {
            fprintf(stderr, "kernel_launch: shape mismatch: n_in %d in0 %d out %d ws %zu (need %zu)\n", n_in, n_in > 0 ? in_sizes[0] : -1, out_size, ws_size, (size_t)WS_END); grid = -1; return; }
        int dev = 0, cus = 0, per_cu = 0;
        if (hipGetDevice(&dev) != hipSuccess || hipDeviceGetAttribute(&cus, hipDeviceAttributeMultiprocessorCount, dev) != hipSuccess) { grid = -1; return; }
        if (hipFuncSetAttribute((const void*)hybrid_fwd, hipFuncAttributeMaxDynamicSharedMemorySize, LDS_BYTES) != hipSuccess) { fprintf(stderr, "kernel_launch: hipFuncSetAttribute failed\n"); grid = -1; return; }
        if (hipOccupancyMaxActiveBlocksPerMultiprocessor(&per_cu, (const void*)hybrid_fwd, NWAVES * 64, LDS_BYTES) != hipSuccess || per_cu < 1)
            fprintf(stderr, "kernel_launch: occupancy query reports %d workgroups per CU\n", per_cu);
        (void)hipGetLastError();
        grid = cus;
    }
    if (grid < 0) return;
    if (hipMemsetAsync((char*)d_ws + WS_CTL, 0, CTL_ZERO_BYTES, stream) != hipSuccess) { fprintf(stderr, "kernel_launch: memset failed\n"); return; }
    Args a{};
    for (int i = 0; i < N_IN; ++i) a.in[i] = (const float*)d_in[i];
    a.out = (float*)d_out; a.ws = (unsigned char*)d_ws;
#if MK_PER_PHASE
#ifndef PROBE_REP_MASK
#define PROBE_REP_MASK 0
#endif
#ifndef PROBE_REPS
#define PROBE_REPS 1
#endif
    for (int p = 0; p < N_PHASES; ++p) { a.ph_lo = p; a.ph_hi = p + 1; const int reps = 1 + (((PROBE_REP_MASK) >> p) & 1) * (PROBE_REPS);
        for (int r = 0; r < reps; ++r) hipLaunchKernelGGL(hybrid_fwd, dim3(grid), dim3(NWAVES * 64), LDS_BYTES, stream, a); }
#else
    a.ph_lo = 0; a.ph_hi = N_PHASES; hipLaunchKernelGGL(hybrid_fwd, dim3(grid), dim3(NWAVES * 64), LDS_BYTES, stream, a);
#endif
    const hipError_t le = hipPeekAtLastError();
    if (le != hipSuccess) fprintf(stderr, "kernel_launch: launch failed: %s\n", hipGetErrorName(le));
}
```
